# Optimizing an MI355X kernel written in HIP

```python
import math
import jax, jax.numpy as jnp
from jax import lax
import numpy as np

D_MODEL = 1024
BATCH = 8
SEQ = 2048
DEPTH = 4

HEAD_DIM = 64
N_HEADS_TOTAL = D_MODEL // HEAD_DIM
N_HEADS_MOBA = N_HEADS_TOTAL // 2
N_HEADS_SWA = N_HEADS_TOTAL - N_HEADS_MOBA
N_KV_SWA = 2
GQA_GROUP = N_HEADS_SWA // N_KV_SWA
MIX_WIDTH = N_HEADS_TOTAL * HEAD_DIM
MOBA_BLOCK = 256
MOBA_TOPK = 3
MOBA_QCHUNK = 16
SWA_WINDOW = 128
N_BUCKETS = 32
MAX_DISTANCE = 128
D_FF = 4 * D_MODEL
EPS = 1e-6
W_A = N_HEADS_MOBA * HEAD_DIM
W_QB = N_HEADS_SWA * HEAD_DIM
W_KVB = N_KV_SWA * HEAD_DIM
D_IN = 3 * W_A + W_QB + 2 * W_KVB

kernel_name = "hybrid_moba_swa_sandwich_adaln"


def rmsnorm(x, g):
    xf = x.astype(jnp.float32)
    y = xf * lax.rsqrt(jnp.mean(xf * xf, axis=-1, keepdims=True) + EPS)
    return (y * g.astype(jnp.float32)).astype(x.dtype)


def t5_bucket(dist):
    n = jnp.maximum(dist, 0)
    max_exact = N_BUCKETS // 2
    nf = jnp.maximum(n, 1).astype(jnp.float32)
    large = max_exact + (jnp.log(nf / max_exact) / math.log(MAX_DISTANCE / max_exact)
                         * (N_BUCKETS - max_exact)).astype(jnp.int32)
    large = jnp.minimum(large, N_BUCKETS - 1)
    return jnp.where(n < max_exact, n, large)


def moba_attention(q, k, v, bias_hb):
    B, H, S, dh = q.shape
    nb = -(-S // MOBA_BLOCK)
    sp = nb * MOBA_BLOCK
    padw = ((0, 0), (0, 0), (0, sp - S), (0, 0))
    q, k, v = jnp.pad(q, padw), jnp.pad(k, padw), jnp.pad(v, padw)
    kb = k.reshape(B, H, nb, MOBA_BLOCK, dh)
    vb = v.reshape(B, H, nb, MOBA_BLOCK, dh)
    k_mean = jnp.mean(kb.astype(jnp.float32), axis=3)
    gate = jnp.einsum('bhsd,bhnd->bhsn', q.astype(jnp.float32), k_mean)
    q_block = jnp.arange(sp) // MOBA_BLOCK
    fully_past = jnp.arange(nb)[None, :] < q_block[:, None]
    gate = jnp.where(fully_past, gate, -jnp.inf)
    n_sel = min(MOBA_TOPK, nb)
    sel_score, sel_idx = lax.top_k(gate, n_sel)
    sel_valid = jnp.isfinite(sel_score)
    scale = dh ** -0.5
    b_idx = jnp.arange(B)[:, None, None, None]
    h_idx = jnp.arange(H)[None, :, None, None]
    offs = jnp.arange(MOBA_BLOCK)

    def chunk(ci):
        q0 = ci * MOBA_QCHUNK
        qc = lax.dynamic_slice_in_dim(q, q0, MOBA_QCHUNK, axis=2)
        idx = lax.dynamic_slice_in_dim(sel_idx, q0, MOBA_QCHUNK, axis=2)
        valid = lax.dynamic_slice_in_dim(sel_valid, q0, MOBA_QCHUNK, axis=2)
        qpos = q0 + jnp.arange(MOBA_QCHUNK)
        k_sel = kb[b_idx, h_idx, idx]
        v_sel = vb[b_idx, h_idx, idx]
        s_sel = jnp.einsum('bhqd,bhqnjd->bhqnj', qc, k_sel).astype(jnp.float32) * scale
        kpos_sel = idx[..., None] * MOBA_BLOCK + offs
        s_sel = s_sel + bias_hb[h_idx[..., None], t5_bucket(qpos[:, None, None] - kpos_sel)]
        s_sel = jnp.where(valid[..., None], s_sel, -jnp.inf)
        ob = q0 // MOBA_BLOCK
        k_own = lax.dynamic_slice_in_dim(k, ob * MOBA_BLOCK, MOBA_BLOCK, axis=2)
        v_own = lax.dynamic_slice_in_dim(v, ob * MOBA_BLOCK, MOBA_BLOCK, axis=2)
        s_own = jnp.einsum('bhqd,bhjd->bhqj', qc, k_own).astype(jnp.float32) * scale
        dist = qpos[:, None] - (ob * MOBA_BLOCK + offs)[None, :]
        s_own = s_own + bias_hb[:, t5_bucket(dist)][None]
        s_own = jnp.where(dist >= 0, s_own, -jnp.inf)
        logits = jnp.concatenate(
            [s_sel.reshape(B, H, MOBA_QCHUNK, n_sel * MOBA_BLOCK), s_own], axis=-1)
        p = jax.nn.softmax(logits, axis=-1)
        p_sel = p[..., :n_sel * MOBA_BLOCK].reshape(B, H, MOBA_QCHUNK, n_sel, MOBA_BLOCK).astype(v.dtype)
        p_own = p[..., n_sel * MOBA_BLOCK:].astype(v.dtype)
        return (jnp.einsum('bhqnj,bhqnjd->bhqd', p_sel, v_sel)
                + jnp.einsum('bhqj,bhjd->bhqd', p_own, v_own))

    outs = lax.map(chunk, jnp.arange(sp // MOBA_QCHUNK))
    out = jnp.moveaxis(outs, 0, 2).reshape(B, H, sp, dh)
    return out[:, :, :S]


def swa_attention(q, k, v, bias_hb, sinks):
    B, HKV, G, S, dh = q.shape
    W = SWA_WINDOW
    nbq = S // W
    qb = q.reshape(B, HKV, G, nbq, W, dh)
    kb = k.reshape(B, HKV, nbq, W, dh)
    vb = v.reshape(B, HKV, nbq, W, dh)
    pad_prev = ((0, 0), (0, 0), (1, 0), (0, 0), (0, 0))
    k_band = jnp.concatenate([jnp.pad(kb[:, :, :-1], pad_prev), kb], axis=3)
    v_band = jnp.concatenate([jnp.pad(vb[:, :, :-1], pad_prev), vb], axis=3)
    s = jnp.einsum('bkgnqd,bknjd->bkgnqj', qb, k_band).astype(jnp.float32) * (dh ** -0.5)
    blk = jnp.arange(nbq)
    qpos = blk[:, None] * W + jnp.arange(W)[None, :]
    kpos = (blk[:, None] - 1) * W + jnp.arange(2 * W)[None, :]
    dist = qpos[:, :, None] - kpos[:, None, :]
    allowed = (dist >= 0) & (dist < W) & (kpos[:, None, :] >= 0)
    bias = bias_hb[:, t5_bucket(dist)].reshape(HKV, G, nbq, W, 2 * W)
    s = jnp.where(allowed, s + bias, -jnp.inf)
    sink = jnp.broadcast_to(sinks.astype(jnp.float32).reshape(1, HKV, G, 1, 1, 1), s.shape[:-1] + (1,))
    p = jax.nn.softmax(jnp.concatenate([s, sink], axis=-1), axis=-1)[..., :-1]
    out = jnp.einsum('bkgnqj,bknjd->bkgnqd', p.astype(v.dtype), v_band)
    return out.reshape(B, HKV, G, S, dh)


def token_mixer(h, w_in, w_out, sinks, bias_hb):
    B, S, _ = h.shape
    proj = h @ w_in
    qa, ka, va, qb, kb, vb = jnp.split(
        proj, [W_A, 2 * W_A, 3 * W_A, 3 * W_A + W_QB, 3 * W_A + W_QB + W_KVB], axis=-1)
    heads = lambda t, n: t.reshape(B, S, n, HEAD_DIM).transpose(0, 2, 1, 3)
    out_a = moba_attention(heads(qa, N_HEADS_MOBA), heads(ka, N_HEADS_MOBA),
                           heads(va, N_HEADS_MOBA), bias_hb[:N_HEADS_MOBA])
    out_a = out_a.transpose(0, 2, 1, 3).reshape(B, S, W_A)
    q_swa = qb.reshape(B, S, N_KV_SWA, GQA_GROUP, HEAD_DIM).transpose(0, 2, 3, 1, 4)
    out_b = swa_attention(q_swa, heads(kb, N_KV_SWA), heads(vb, N_KV_SWA),
                          bias_hb[N_HEADS_MOBA:], sinks)
    out_b = out_b.transpose(0, 3, 1, 2, 4).reshape(B, S, W_QB)
    return jnp.concatenate([out_a, out_b], axis=-1) @ w_out


def setup_inputs(seed: int = 0) -> dict:
    key = jax.random.key(seed)
    ks = jax.random.split(key, 13)
    f32 = jnp.float32
    nrm = lambda k, shape, s: jax.random.normal(k, shape, f32) * s
    return {
        "x": nrm(ks[0], (BATCH, SEQ, D_MODEL), 1.0),
        "c": nrm(ks[1], (BATCH, D_MODEL), 1.0),
        "w_in": nrm(ks[2], (DEPTH, D_MODEL, D_IN), D_MODEL ** -0.5),
        "w_out": nrm(ks[3], (DEPTH, MIX_WIDTH, D_MODEL), MIX_WIDTH ** -0.5),
        "sinks": nrm(ks[4], (DEPTH, N_HEADS_SWA), 0.5),
        "rel_bias": nrm(ks[5], (N_BUCKETS, N_HEADS_TOTAL), 0.5),
        "w_ada": nrm(ks[6], (DEPTH, D_MODEL, 6 * D_MODEL), D_MODEL ** -0.5),
        "b_ada": nrm(ks[7], (DEPTH, 6 * D_MODEL), 0.02),
        "norm_gains": 1.0 + nrm(ks[8], (DEPTH, 4, D_MODEL), 0.05),
        "w1": nrm(ks[9], (DEPTH, D_MODEL, D_FF), D_MODEL ** -0.5),
        "b1": nrm(ks[10], (DEPTH, D_FF), 0.02),
        "w2": nrm(ks[11], (DEPTH, D_FF, D_MODEL), D_FF ** -0.5),
        "b2": nrm(ks[12], (DEPTH, D_MODEL), 0.02),
    }


def reference(x, c, w_in, w_out, sinks, rel_bias, w_ada, b_ada, norm_gains, w1, b1, w2, b2):
    bias_hb = rel_bias.T
    c_act = jax.nn.silu(c)
    for l in range(DEPTH):
        mod = c_act @ w_ada[l] + b_ada[l]
        sh1, sc1, g1, sh2, sc2, g2 = [m[:, None, :] for m in jnp.split(mod, 6, axis=-1)]
        h = rmsnorm(x, norm_gains[l, 0]) * (1.0 + sc1) + sh1
        y = token_mixer(h, w_in[l], w_out[l], sinks[l], bias_hb)
        x = x + g1 * rmsnorm(y, norm_gains[l, 1])
        h = rmsnorm(x, norm_gains[l, 2]) * (1.0 + sc2) + sh2
        y = jnp.square(jax.nn.relu(h @ w1[l] + b1[l])) @ w2[l] + b2[l]
        x = x + g2 * rmsnorm(y, norm_gains[l, 3])
    return x
```

```cpp
#include <hip/hip_runtime.h>
#include <cstdio>
#include <cstdint>
#include <cmath>

#ifndef MK_PER_PHASE
#define MK_PER_PHASE 0
#endif

typedef _Float16 f16x8 __attribute__((ext_vector_type(8)));
typedef _Float16 f16x2 __attribute__((ext_vector_type(2)));
typedef unsigned short f16_t;
__device__ __forceinline__ unsigned pk_f16(float lo, float hi) { f16x2 v = {(_Float16)lo, (_Float16)hi}; return __builtin_bit_cast(unsigned, v); }

namespace pg8 {
#define PG8_LAS __attribute__((address_space(3)))
typedef unsigned short bf16_t;

typedef float f32x4 __attribute__((ext_vector_type(4)));
typedef unsigned u32x4 __attribute__((ext_vector_type(4)));
constexpr int BM = 256, BK = 64, HALF = 128, HTB = HALF * BK * 2  , STAGE_BYTES = 8 * HTB, NXCD = 8, WGM = 8;

__host__ __device__ __forceinline__ int lds_byte(int r, int c) { const int st = (r >> 4) * 2 + (c >> 5), rr = r & 15, cc = c & 31, ob = rr * 64 + cc * 2; return st * 1024 + (ob ^ (((ob >> 9) & 1) << 5)); }
__host__ __device__ __forceinline__ void stage_rc(int b, int& R, int& C) { const int st = b / 1024, sb = b % 1024, swz = sb ^ (((sb >> 9) & 1) << 5); R = (st >> 1) * 16 + swz / 64; C = (st & 1) * 32 + (swz % 64) / 2; }
__host__ __device__ __forceinline__ int perm32(int rho) { const int n = rho >> 4, i = rho & 15; return 8 * (i >> 2) + 4 * n + (i & 3); }

struct Unit { int pm, pn; };
struct Gemm { const bf16_t* A; const bf16_t* Bt; int M, N, K; };

struct StaticOrder {
    int nM, nN, nwg, G, c;
    __host__ __device__ void init(int M, int N, int G_, int c_) { nM = M / BM; nN = N / BM; nwg = nM * nN; G = G_; c = c_; }
    __host__ __device__ bool next(int i, Unit& u) const {
        const long L = (long)i * G + c; if (L >= nwg) return false;
        int wgid = (int)L; { const int q = nwg / NXCD, r = nwg % NXCD, xcd = wgid % NXCD, off = wgid / NXCD; wgid = (xcd < r ? xcd * (q + 1) : r * (q + 1) + (xcd - r) * q) + off; }
        const int nig = WGM * nN, gid = wgid / nig, fm = gid * WGM, gsz = (nM - fm) < WGM ? (nM - fm) : WGM;
        u.pm = fm + ((wgid % nig) % gsz); u.pn = (wgid % nig) / gsz; return true;
    }
    __device__ __forceinline__ void a_ready(const Unit&) const {}
    __device__ __forceinline__ void done(const Unit&) const {}
};

struct EpiProj {
    static constexpr bool PERM = true, AFTER_DRAIN = false;
    bf16_t* O; float* kpart; float qscale;
    __device__ __forceinline__ void operator()(const f32x4 (&acc)[2][2][4][2], const Unit& u, int wr, int wc, int fr, int fq) const {
        constexpr int ldc = 2304;
        const int row0 = u.pm * BM + wr * 64 + fr, colt = u.pn * BM, col0 = colt + wc * 32 + 8 * fq;
        const float sc = (u.pn < 2 || (u.pn >= 6 && u.pn < 8)) ? qscale : 1.f;
#pragma unroll
        for (int ai = 0; ai < 2; ++ai)
#pragma unroll
            for (int m = 0; m < 4; ++m) { bf16_t* rowp = O + (size_t)(row0 + ai * HALF + m * 16) * ldc + col0;
#pragma unroll
                for (int bj = 0; bj < 2; ++bj) { const f32x4 v0 = acc[ai][bj][m][0] * sc, v1 = acc[ai][bj][m][1] * sc;
                    u32x4 w; w.x = pk_f16(v0[0], v0[1]); w.y = pk_f16(v0[2], v0[3]); w.z = pk_f16(v1[0], v1[1]); w.w = pk_f16(v1[2], v1[3]);
                    *(u32x4*)(rowp + bj * HALF) = w; } }
        if (u.pn == 2 || u.pn == 3) {
#pragma unroll
            for (int bj = 0; bj < 2; ++bj) {
                f32x4 s0 = {0.f, 0.f, 0.f, 0.f}, s1 = {0.f, 0.f, 0.f, 0.f};
#pragma unroll
                for (int ai = 0; ai < 2; ++ai)
#pragma unroll
                    for (int m = 0; m < 4; ++m) { s0 += acc[ai][bj][m][0]; s1 += acc[ai][bj][m][1]; }
#pragma unroll
                for (int o = 1; o < 16; o <<= 1) {
#pragma unroll
                    for (int i = 0; i < 4; ++i) { s0[i] += __shfl_xor(s0[i], o); s1[i] += __shfl_xor(s1[i], o); } }
                if (fr == 0) { float* kp = kpart + (size_t)(u.pm * 2 + wr) * 512 + (colt - 512) + bj * HALF + wc * 32 + 8 * fq; *(f32x4*)kp = s0; *(f32x4*)(kp + 4) = s1; }
            }
        }
    }
};
struct EpiSqRelu {
    static constexpr bool PERM = true, AFTER_DRAIN = false;
    bf16_t* O; int ldc; const float* bias;
    __device__ __forceinline__ void operator()(const f32x4 (&acc)[2][2][4][2], const Unit& u, int wr, int wc, int fr, int fq) const {
        const int row0 = u.pm * BM + wr * 64 + fr, col0 = u.pn * BM + wc * 32 + 8 * fq;
        f32x4 bv[2][2];
#pragma unroll
        for (int bj = 0; bj < 2; ++bj)
#pragma unroll
            for (int n = 0; n < 2; ++n) bv[bj][n] = *(const f32x4*)(bias + col0 + bj * HALF + 4 * n);
#pragma unroll
        for (int ai = 0; ai < 2; ++ai)
#pragma unroll
            for (int m = 0; m < 4; ++m) { bf16_t* rowp = O + (size_t)(row0 + ai * HALF + m * 16) * ldc + col0;
#pragma unroll
                for (int bj = 0; bj < 2; ++bj) { f32x4 v0 = acc[ai][bj][m][0] + bv[bj][0], v1 = acc[ai][bj][m][1] + bv[bj][1];
#pragma unroll
                    for (int i = 0; i < 4; ++i) { const float a = fmaxf(v0[i], 0.f), b = fmaxf(v1[i], 0.f); v0[i] = a * a; v1[i] = b * b; }
                    u32x4 w; w.x = pk_f16(v0[0], v0[1]); w.y = pk_f16(v0[2], v0[3]); w.z = pk_f16(v1[0], v1[1]); w.w = pk_f16(v1[2], v1[3]);
                    *(u32x4*)(rowp + bj * HALF) = w; } }
    }
};
struct EpiF32 {
    static constexpr bool PERM = false, AFTER_DRAIN = false;
    float* O; int ldc; const float* bias;
    __device__ __forceinline__ void operator()(const f32x4 (&acc)[2][2][4][2], const Unit& u, int wr, int wc, int fr, int fq) const {
        const int row0 = u.pm * BM + wr * 64 + fr, col0 = u.pn * BM + wc * 32 + 4 * fq;
        f32x4 bv[2][2];
#pragma unroll
        for (int bj = 0; bj < 2; ++bj)
#pragma unroll
            for (int n = 0; n < 2; ++n) bv[bj][n] = bias ? *(const f32x4*)(bias + col0 + bj * HALF + n * 16) : (f32x4){0.f, 0.f, 0.f, 0.f};
#pragma unroll
        for (int ai = 0; ai < 2; ++ai)
#pragma unroll
            for (int m = 0; m < 4; ++m) { float* rowp = O + (size_t)(row0 + ai * HALF + m * 16) * ldc + col0;
#pragma unroll
                for (int bj = 0; bj < 2; ++bj)
#pragma unroll
                    for (int n = 0; n < 2; ++n) *(f32x4*)(rowp + bj * HALF + n * 16) = acc[ai][bj][m][n] + bv[bj][n]; }
    }
};

template <class Epi, class Sched, bool ALIGN_EPI = false, bool SP2 = false>
__device__ __forceinline__ void gemm_phase(PG8_LAS unsigned char* lds, const Gemm g, const Sched& S, const Epi& E) {
    int tid_ = threadIdx.x; asm volatile("" : "+v"(tid_));
    const int tid = tid_, wid = __builtin_amdgcn_readfirstlane(tid >> 6), lane = tid & 63, wr = wid >> 2, wc = wid & 3, fr = lane & 15, fq = lane >> 4;
    const int K = g.K, nt = K / BK;
    unsigned voffA[2], voffB[2];
#pragma unroll
    for (int i = 0; i < 2; ++i) { int R, C; stage_rc(tid * 16 + i * 8192, R, C); const int Rb = Epi::PERM ? ((R & ~31) + perm32(R & 31)) : R;
        voffA[i] = (unsigned)(R * K + C) * 2u; voffB[i] = (unsigned)(Rb * K + C) * 2u; }
    const size_t kstep = (size_t)(BK * 2);
    const size_t hstep = (size_t)HALF * K * 2;
    const size_t tstep = 2 * hstep;
    const unsigned ldsw = (unsigned)wid * 1024u;
    const int aoff = lds_byte(wr * 64 + fr, fq * 8), boff = lds_byte(wc * 32 + fr, fq * 8);
#define PG8_SA(b, h) (((b) * 2 + (h)) * HTB)
#define PG8_SB(b, h) ((4 + (b) * 2 + (h)) * HTB)
#define PG8_STAGE(bufoff, gbase, voff) do { _Pragma("unroll") for (int _i = 0; _i < 2; ++_i) \
        __builtin_amdgcn_global_load_lds((const unsigned*)((const char*)(gbase) + (voff)[_i]), (PG8_LAS unsigned*)(lds + (bufoff) + ldsw + _i * 8192), 16, 0, 0); } while (0)
#define PG8_LDA(dst, b, h) do { _Pragma("unroll") for (int m = 0; m < 4; ++m) _Pragma("unroll") for (int k = 0; k < 2; ++k) dst[m][k] = *(const PG8_LAS f16x8*)(lds + PG8_SA(b, h) + aoff + m * 2048 + k * 1024); } while (0)
#define PG8_LDB(dst, b, h) do { _Pragma("unroll") for (int n = 0; n < 2; ++n) _Pragma("unroll") for (int k = 0; k < 2; ++k) dst[n][k] = *(const PG8_LAS f16x8*)(lds + PG8_SB(b, h) + boff + n * 2048 + k * 1024); } while (0)
#define PG8_MMA(ai, bj, At, Bt) do { __builtin_amdgcn_s_setprio(1); _Pragma("unroll") for (int m = 0; m < 4; ++m) _Pragma("unroll") for (int n = 0; n < 2; ++n) _Pragma("unroll") for (int k = 0; k < 2; ++k) \
        acc[ai][bj][m][n] = __builtin_amdgcn_mfma_f32_16x16x32_f16(Bt[n][k], At[m][k], acc[ai][bj][m][n], 0, 0, 0); __builtin_amdgcn_s_setprio(0); } while (0)
#define PG8_WAIT_V(n) asm volatile("s_waitcnt vmcnt(" #n ")" ::: "memory")
#define PG8_WAIT_L(n) asm volatile("s_waitcnt lgkmcnt(" #n ")" ::: "memory")
#define PG8_BAR __builtin_amdgcn_s_barrier()
#define PG8_SCHED __builtin_amdgcn_sched_barrier(0)
    Unit cur, nxt; int ui = 0;
    if (!S.next(0, cur)) return;
    f32x4 acc[2][2][4][2];
#pragma unroll
    for (int a = 0; a < 2; ++a)
#pragma unroll
        for (int b = 0; b < 2; ++b)
#pragma unroll
            for (int m = 0; m < 4; ++m)
#pragma unroll
                for (int n = 0; n < 2; ++n) acc[a][b][m][n] = (f32x4){0.f, 0.f, 0.f, 0.f};
    f16x8 At[4][2], B0[2][2], B1[2][2];
    const char* cA = (const char*)g.A + (size_t)cur.pm * tstep; const char* cB = (const char*)g.Bt + (size_t)cur.pn * tstep;
    S.a_ready(cur);
    if constexpr (SP2) {
        PG8_STAGE(PG8_SB(0, 0), cB, voffB); PG8_STAGE(PG8_SB(0, 1), cB + hstep, voffB); PG8_STAGE(PG8_SA(0, 0), cA, voffA); PG8_STAGE(PG8_SA(0, 1), cA + hstep, voffA);
        if (wr == 1) PG8_BAR;
        PG8_WAIT_V(2); PG8_BAR;
        PG8_STAGE(PG8_SB(1, 0), cB + kstep, voffB); PG8_STAGE(PG8_SA(1, 0), cA + kstep, voffA); PG8_STAGE(PG8_SB(1, 1), cB + hstep + kstep, voffB);
        PG8_WAIT_V(6); PG8_BAR;
    } else {
        PG8_STAGE(PG8_SB(0, 0), cB, voffB); PG8_STAGE(PG8_SA(0, 0), cA, voffA); PG8_STAGE(PG8_SB(0, 1), cB + hstep, voffB); PG8_STAGE(PG8_SA(0, 1), cA + hstep, voffA);
        if (wr == 1) PG8_BAR;
        PG8_WAIT_V(4); PG8_BAR;
        PG8_STAGE(PG8_SB(1, 0), cB + kstep, voffB); PG8_STAGE(PG8_SA(1, 0), cA + kstep, voffA); PG8_STAGE(PG8_SB(1, 1), cB + hstep + kstep, voffB);
        PG8_WAIT_V(6); PG8_BAR;
    }
    for (;;) {
        const bool has_next = S.next(ui + 1, nxt);
        const char* nA = has_next ? (const char*)g.A + (size_t)nxt.pm * tstep : cA; const char* nB = has_next ? (const char*)g.Bt + (size_t)nxt.pn * tstep : cB;
        for (int t = 0; t < nt; t += 2) {
            const bool last = (t == nt - 2);
            const char* a1 = cA + (size_t)(t + 1) * kstep;
            const char* a2 = last ? nA : cA + (size_t)(t + 2) * kstep; const char* b2 = last ? nB : cB + (size_t)(t + 2) * kstep;
            const char* a3 = a2 + kstep; const char* b3 = b2 + kstep;
            if (last && has_next) S.a_ready(nxt);
            if constexpr (SP2) {
            PG8_LDB(B0, 0, 0); PG8_LDB(B1, 0, 1); PG8_SCHED; PG8_LDA(At, 0, 0); PG8_STAGE(PG8_SA(1, 1), a1 + hstep, voffA);
            PG8_WAIT_V(8); PG8_WAIT_L(0); PG8_BAR; PG8_MMA(0, 0, At, B0); PG8_MMA(0, 1, At, B1); PG8_BAR; PG8_SCHED;
            PG8_LDA(At, 0, 1); PG8_STAGE(PG8_SB(0, 0), b2, voffB); PG8_STAGE(PG8_SB(0, 1), b2 + hstep, voffB); PG8_STAGE(PG8_SA(0, 0), a2, voffA);
            PG8_WAIT_V(8); PG8_WAIT_L(0); PG8_BAR; PG8_MMA(1, 0, At, B0); PG8_MMA(1, 1, At, B1); PG8_BAR; PG8_SCHED;
            PG8_LDB(B0, 1, 0); PG8_LDB(B1, 1, 1); PG8_SCHED; PG8_LDA(At, 1, 0); PG8_STAGE(PG8_SA(0, 1), a2 + hstep, voffA);
            PG8_WAIT_V(8); PG8_WAIT_L(0); PG8_BAR; PG8_MMA(0, 0, At, B0); PG8_MMA(0, 1, At, B1); PG8_BAR; PG8_SCHED;
            PG8_LDA(At, 1, 1); PG8_STAGE(PG8_SB(1, 0), b3, voffB); PG8_STAGE(PG8_SB(1, 1), b3 + hstep, voffB); PG8_STAGE(PG8_SA(1, 0), a3, voffA);
            PG8_WAIT_V(8); PG8_WAIT_L(0); PG8_BAR; PG8_MMA(1, 0, At, B0); PG8_MMA(1, 1, At, B1); PG8_BAR; PG8_SCHED;
            } else {
            PG8_LDB(B0, 0, 0); PG8_SCHED; PG8_LDA(At, 0, 0); PG8_STAGE(PG8_SA(1, 1), a1 + hstep, voffA);
            PG8_WAIT_L(8); PG8_BAR; PG8_WAIT_L(0); PG8_MMA(0, 0, At, B0); PG8_BAR; PG8_SCHED;
            PG8_LDB(B1, 0, 1); PG8_STAGE(PG8_SB(0, 0), b2, voffB);
            PG8_BAR; PG8_WAIT_L(0); PG8_MMA(0, 1, At, B1); PG8_BAR;
            PG8_LDA(At, 0, 1); PG8_STAGE(PG8_SA(0, 0), a2, voffA);
            PG8_BAR; PG8_WAIT_L(0); PG8_MMA(1, 0, At, B0); PG8_BAR; PG8_SCHED;
            PG8_STAGE(PG8_SB(0, 1), b2 + hstep, voffB);
            PG8_WAIT_V(6); PG8_BAR; PG8_MMA(1, 1, At, B1); PG8_BAR;
            PG8_LDB(B0, 1, 0); PG8_SCHED; PG8_LDA(At, 1, 0); PG8_STAGE(PG8_SA(0, 1), a2 + hstep, voffA);
            PG8_WAIT_L(8); PG8_BAR; PG8_WAIT_L(0); PG8_MMA(0, 0, At, B0); PG8_BAR; PG8_SCHED;
            PG8_LDB(B1, 1, 1); PG8_STAGE(PG8_SB(1, 0), b3, voffB);
            PG8_BAR; PG8_WAIT_L(0); PG8_MMA(0, 1, At, B1); PG8_BAR;
            PG8_LDA(At, 1, 1); PG8_STAGE(PG8_SA(1, 0), a3, voffA);
            PG8_BAR; PG8_WAIT_L(0); PG8_MMA(1, 0, At, B0); PG8_BAR; PG8_SCHED;
            PG8_STAGE(PG8_SB(1, 1), b3 + hstep, voffB);
            PG8_WAIT_V(6); PG8_BAR; PG8_MMA(1, 1, At, B1); PG8_BAR;
            }
        }
        if constexpr (ALIGN_EPI) { if (wr == 0) PG8_BAR; }
        if constexpr (!Epi::AFTER_DRAIN) { E(acc, cur, wr, wc, fr, fq); S.done(cur); }
        if (!has_next) break;
#pragma unroll
        for (int a = 0; a < 2; ++a)
#pragma unroll
            for (int b = 0; b < 2; ++b)
#pragma unroll
                for (int m = 0; m < 4; ++m)
#pragma unroll
                    for (int n = 0; n < 2; ++n) acc[a][b][m][n] = (f32x4){0.f, 0.f, 0.f, 0.f};
        cur = nxt; cA = nA; cB = nB; ++ui;
        if constexpr (ALIGN_EPI) { if (wr == 1) PG8_BAR; }
    }
    PG8_WAIT_V(0);
    if constexpr (!ALIGN_EPI) { if (wr == 0) PG8_BAR; }
    PG8_BAR;
    if constexpr (Epi::AFTER_DRAIN) { E.fused(acc, cur, wr, wc, fr, fq, lds, wid, lane); S.done(cur); }
#undef PG8_SA
#undef PG8_SB
#undef PG8_STAGE
#undef PG8_LDA
#undef PG8_LDB
#undef PG8_MMA
#undef PG8_WAIT_V
#undef PG8_WAIT_L
#undef PG8_BAR
#undef PG8_SCHED
}
}
namespace att {
#define ALAS __attribute__((address_space(3)))
typedef float f32x16 __attribute__((ext_vector_type(16)));
typedef float f32x4a __attribute__((ext_vector_type(4)));
typedef short v4i16_t __attribute__((ext_vector_type(4)));
typedef unsigned u32x4a __attribute__((ext_vector_type(4)));
typedef unsigned u32x2a __attribute__((ext_vector_type(2)));
constexpr int SEQ = 2048, PITCH = 2304, OPITCH = 1024;
constexpr int SLOTB = 8192, NSLOT = 3;
constexpr int TBL_N = 640;
constexpr int L_K = 0, L_V = NSLOT * SLOTB, L_TBL = 2 * NSLOT * SLOTB, L_KM = L_TBL + 4 * TBL_N * 4, L_END = L_KM + 8 * 64 * 4;
constexpr float LOG2E = 1.4426950408889634f, C2 = 0.125f * LOG2E;
__constant__ unsigned char T5B[128] = {0,1,2,3,4,5,6,7,8,9,10,11,12,13,14,15,16,16,16,17,17,18,18,18,19,19,19,20,20,20,20,21,21,21,21,22,22,22,22,22,23,23,23,23,23,23,24,24,24,24,24,24,
    25,25,25,25,25,25,25,26,26,26,26,26,26,26,26,27,27,27,27,27,27,27,27,27,27,28,28,28,28,28,28,28,28,28,28,29,29,29,29,29,29,29,29,29,29,29,29,30,30,30,30,30,30,30,30,30,30,30,30,30,30,
    31,31,31,31,31,31,31,31,31,31,31,31,31,31,31};
__device__ __forceinline__ void glds16(const void* gsrc, unsigned lds_dst) { unsigned keep;
    asm volatile("s_mov_b32 %0, m0\n\ts_mov_b32 m0, %2\n\ts_nop 0\n\tglobal_load_lds_dwordx4 %1, off\n\ts_mov_b32 m0, %0" : "=&s"(keep) : "v"(gsrc), "s"(lds_dst) : "memory"); }
#define ATT_WAIT_BAR(N) asm volatile("s_waitcnt vmcnt(" #N ") lgkmcnt(0)\n\ts_barrier" ::: "memory")
__device__ __forceinline__ float swap_max(float v) { auto rr = __builtin_amdgcn_permlane32_swap(__float_as_uint(v), __float_as_uint(v), false, false); return fmaxf(__uint_as_float(rr[0]), __uint_as_float(rr[1])); }
__device__ __forceinline__ float swap_sum(float v) { auto rr = __builtin_amdgcn_permlane32_swap(__float_as_uint(v), __float_as_uint(v), false, false); return __uint_as_float(rr[0]) + __uint_as_float(rr[1]); }

template <bool MOBA>
__device__ __forceinline__ void attn_core(const f16_t* Qrow, const f16_t* Kh, const f16_t* Vh, f16_t* Orow, ALAS unsigned char* shm, const ALAS float* tbl, const ALAS float* kmean,
                                          int qpos, int qw0, int idx, float c31, float sink2, int wid, int lane) {
    const int r32 = lane & 31, hi = lane >> 5;
    const unsigned lds0 = (unsigned)(uintptr_t)shm;
    f16x8 qr[4];
#pragma unroll
    for (int d0 = 0; d0 < 4; ++d0) qr[d0] = *(const f16x8*)(Qrow + d0 * 16 + hi * 8);
    const int NT = MOBA ? 4 * (idx + 1) : (idx + 1 < 3 ? idx + 1 : 3);
    const f16_t* ksrc = Kh + (size_t)lane * PITCH + wid * 8;
    const f16_t* vsrc = Vh + (size_t)(16 * (wid & 3) + (lane >> 2)) * PITCH + (wid >> 2) * 32 + (lane & 3) * 8;
    const unsigned kdst = lds0 + L_K + wid * 1024, vdst = lds0 + L_V + wid * 1024;
#define ATT_KT(i) (MOBA ? ((i) < 4 ? 4 * idx + (i) : 4 * (idx - 1 - (((i) - 4) >> 2)) + (((i) - 4) & 3)) : idx - (i))
#define ATT_DMA(i, slot) do { const int kt_ = ATT_KT(i); glds16(ksrc + (size_t)kt_ * 64 * PITCH, (unsigned)__builtin_amdgcn_readfirstlane(kdst + (slot) * SLOTB)); \
                              glds16(vsrc + (size_t)kt_ * 64 * PITCH, (unsigned)__builtin_amdgcn_readfirstlane(vdst + (slot) * SLOTB)); } while (0)
    ATT_DMA(0, 0);
    if (NT > 1) ATT_DMA(1, 1);
    unsigned selmask = 0u;
    if (MOBA && idx > 0) {
        if (idx <= 3) selmask = (1u << idx) - 1u;
        else {
            float g[7];
#pragma unroll
            for (int n = 0; n < 7; ++n) {
                float a = -INFINITY;
                if (n < idx) { a = 0.f;
#pragma unroll
                    for (int d0 = 0; d0 < 4; ++d0) { const f32x4a k0 = *(const ALAS f32x4a*)(kmean + n * 64 + d0 * 16 + hi * 8), k1 = *(const ALAS f32x4a*)(kmean + n * 64 + d0 * 16 + hi * 8 + 4);
                        a += (float)qr[d0][0] * k0[0] + (float)qr[d0][1] * k0[1] + (float)qr[d0][2] * k0[2] + (float)qr[d0][3] * k0[3]
                           + (float)qr[d0][4] * k1[0] + (float)qr[d0][5] * k1[1] + (float)qr[d0][6] * k1[2] + (float)qr[d0][7] * k1[3]; }
                    a = swap_sum(a); }
                g[n] = a; }
#pragma unroll
            for (int n = 0; n < 7; ++n) { int rank = 0;
#pragma unroll
                for (int m2 = 0; m2 < 7; ++m2) if (m2 != n) rank += (g[m2] > g[n] || (g[m2] == g[n] && m2 < n)) ? 1 : 0;
                if (n < idx && rank < 3) selmask |= 1u << n; }
        }
    }
    float mrun = -INFINITY, lrun = 0.f; f32x16 o0 = {}, o1 = {};
    const ALAS unsigned char* kp0 = shm + L_K + hi * 1024 + r32 * 16;
    const ALAS unsigned char* vp0 = shm + L_V + ((lane >> 4) & 1) * 32 + (lane & 3) * 8 + (4 * hi + ((lane & 15) >> 2)) * 64;
    for (int i = 0; i < NT; ++i) {
        if (i + 1 < NT) ATT_WAIT_BAR(2); else ATT_WAIT_BAR(0);
        if (i + 2 < NT) { const int sl = (i + 2) % NSLOT; ATT_DMA(i + 2, sl); }
        const int slot = (i % NSLOT) * SLOTB;
        const int k0 = ATT_KT(i) * 64;
        bool compute, near; float cinit;
        if (MOBA) {
            if (i < 4) { compute = (k0 <= qw0 + 31); near = true; cinit = 0.f; }
            else { const int n = idx - 1 - ((i - 4) >> 2); const bool sel = ((selmask >> n) & 1u) != 0u; compute = __any(sel) != 0; near = (qw0 - (k0 + 63) < 113);
                   cinit = sel ? (near ? 0.f : c31) : -INFINITY; }
        } else { compute = true; near = true; cinit = 0.f; }
        if (compute) {
            f32x16 p0, p1;
#pragma unroll
            for (int r = 0; r < 16; ++r) { p0[r] = cinit; p1[r] = cinit; }
            const ALAS unsigned char* kp = kp0 + slot;
#pragma unroll
            for (int d0 = 0; d0 < 4; ++d0) { const f16x8 b0 = *(const ALAS f16x8*)(kp + d0 * 2048), b1 = *(const ALAS f16x8*)(kp + d0 * 2048 + 512);
                p0 = __builtin_amdgcn_mfma_f32_32x32x16_f16(b0, qr[d0], p0, 0, 0, 0); p1 = __builtin_amdgcn_mfma_f32_32x32x16_f16(b1, qr[d0], p1, 0, 0, 0); }
            if (near) { const ALAS float* tb = tbl + (qpos - k0 - 4 * hi + 256 - 64);
#pragma unroll
                for (int r = 0; r < 16; ++r) { const int cr = (r & 3) + 8 * (r >> 2); p0[r] += tb[64 - cr]; p1[r] += tb[32 - cr]; } }
            float rm = p0[0];
#pragma unroll
            for (int r = 1; r < 16; ++r) rm = fmaxf(rm, p0[r]);
#pragma unroll
            for (int r = 0; r < 16; ++r) rm = fmaxf(rm, p1[r]);
            rm = swap_max(rm);
            const float mnew = fmaxf(mrun, rm), msafe = (mnew == -INFINITY) ? 0.f : mnew;
            const float alpha = __builtin_amdgcn_exp2f(mrun - msafe);
            float ls = 0.f;
#pragma unroll
            for (int r = 0; r < 16; ++r) { p0[r] = __builtin_amdgcn_exp2f(p0[r] - msafe); p1[r] = __builtin_amdgcn_exp2f(p1[r] - msafe); ls += p0[r] + p1[r]; }
            lrun = lrun * alpha + ls; mrun = mnew;
            if (__any(alpha != 1.0f)) {
#pragma unroll
                for (int r = 0; r < 16; ++r) { o0[r] *= alpha; o1[r] *= alpha; } }
            u32x4a pw[4];
#pragma unroll
            for (int j = 0; j < 4; ++j) { pw[0][j] = pk_f16(p0[2 * j], p0[2 * j + 1]); pw[1][j] = pk_f16(p0[8 + 2 * j], p0[8 + 2 * j + 1]);
                                          pw[2][j] = pk_f16(p1[2 * j], p1[2 * j + 1]); pw[3][j] = pk_f16(p1[8 + 2 * j], p1[8 + 2 * j + 1]); }
            const ALAS unsigned char* vp = vp0 + slot;
#pragma unroll
            for (int s = 0; s < 4; ++s) {
                const f16x8 pf = __builtin_bit_cast(f16x8, pw[s]);
#pragma unroll
                for (int d0 = 0; d0 < 2; ++d0) {
                    const v4i16_t lo = __builtin_amdgcn_ds_read_tr16_b64_v4i16((ALAS v4i16_t*)(vp + d0 * 4096 + s * 1024));
                    const v4i16_t hv = __builtin_amdgcn_ds_read_tr16_b64_v4i16((ALAS v4i16_t*)(vp + d0 * 4096 + s * 1024 + 512));
                    typedef short s16x8 __attribute__((ext_vector_type(8)));
                    const s16x8 vv = {lo[0], lo[1], lo[2], lo[3], hv[0], hv[1], hv[2], hv[3]};
                    const f16x8 vf = __builtin_bit_cast(f16x8, vv);
                    if (d0 == 0) o0 = __builtin_amdgcn_mfma_f32_32x32x16_f16(vf, pf, o0, 0, 0, 0); else o1 = __builtin_amdgcn_mfma_f32_32x32x16_f16(vf, pf, o1, 0, 0, 0);
                }
            }
        }
    }
    float lt = swap_sum(lrun);
    if (!MOBA) lt += __builtin_amdgcn_exp2f(sink2 - mrun);
    const float inv = 1.0f / lt;
#pragma unroll
    for (int g = 0; g < 4; ++g) {
        u32x2a w0, w1; w0.x = pk_f16(o0[4 * g] * inv, o0[4 * g + 1] * inv); w0.y = pk_f16(o0[4 * g + 2] * inv, o0[4 * g + 3] * inv);
        w1.x = pk_f16(o1[4 * g] * inv, o1[4 * g + 1] * inv); w1.y = pk_f16(o1[4 * g + 2] * inv, o1[4 * g + 3] * inv);
        *(u32x2a*)(Orow + 8 * g + 4 * hi) = w0; *(u32x2a*)(Orow + 32 + 8 * g + 4 * hi) = w1; }
    ATT_WAIT_BAR(0);
#undef ATT_KT
#undef ATT_DMA
}

__device__ __forceinline__ float tbl_entry(const float* rel_bias, int head, int i, bool moba) {
    const int dist = i - 256;
    if (dist < 0) return -INFINITY;
    if (dist >= 128) return moba ? rel_bias[31 * 16 + head] * LOG2E : -INFINITY;
    return rel_bias[(int)T5B[dist] * 16 + head] * LOG2E;
}
__device__ __forceinline__ void moba_unit(int b, int h, int qb, const f16_t* proj, f16_t* aout, const float* kpart, const float* rel_bias, ALAS unsigned char* shm, int tid, int wid, int lane) {
    ALAS float* tbl = (ALAS float*)(shm + L_TBL); ALAS float* km = (ALAS float*)(shm + L_KM);
    for (int i = tid; i < TBL_N; i += 512) tbl[i] = tbl_entry(rel_bias, h, i, true);
    for (int i = tid; i < qb * 64; i += 512) { const int n = i >> 6, d = i & 63; const float* kp = kpart + (size_t)((b * 8 + n) * 2) * 512 + h * 64 + d; km[i] = (kp[0] + kp[512]) * (1.0f / 256.0f); }
    ATT_WAIT_BAR(0);
    const size_t rowbase = (size_t)b * SEQ; const int qw0 = qb * 256 + wid * 32, qpos = qw0 + (lane & 31);
    const float c31 = rel_bias[31 * 16 + h] * LOG2E;
    attn_core<true>(proj + (rowbase + qpos) * PITCH + h * 64, proj + rowbase * PITCH + 512 + h * 64, proj + rowbase * PITCH + 1024 + h * 64, aout + (rowbase + qpos) * OPITCH + h * 64,
                    shm, tbl, km, qpos, qw0, qb, c31, 0.f, wid, lane);
}
__device__ __forceinline__ void swa_unit(int b, int kvh, int t, const f16_t* proj, f16_t* aout, const float* sinks, const float* rel_bias, ALAS unsigned char* shm, int tid, int wid, int lane) {
    ALAS float* tbl = (ALAS float*)(shm + L_TBL);
    for (int i = tid; i < 4 * TBL_N; i += 512) { const int g = i / TBL_N, e = i - g * TBL_N; tbl[i] = tbl_entry(rel_bias, 8 + 4 * kvh + g, e, false); }
    ATT_WAIT_BAR(0);
    const int g = wid >> 1, j = 4 * kvh + g;
    const size_t rowbase = (size_t)b * SEQ; const int qw0 = t * 64 + (wid & 1) * 32, qpos = qw0 + (lane & 31);
    attn_core<false>(proj + (rowbase + qpos) * PITCH + 1536 + j * 64, proj + rowbase * PITCH + 2048 + kvh * 64, proj + rowbase * PITCH + 2176 + kvh * 64, aout + (rowbase + qpos) * OPITCH + 512 + j * 64,
                     shm, tbl + g * TBL_N, nullptr, qpos, qw0, t, 0.f, sinks[j] * LOG2E, wid, lane);
}
#undef ATT_WAIT_BAR
}

constexpr int NWAVES = 8;
constexpr int BATCH = 8, SEQ = 2048, D = 1024, DEPTH = 4, DIN = 2304, FF = 4096, M = BATCH * SEQ;
constexpr float EPS = 1e-6f;
constexpr size_t MiB = 1u << 20;
constexpr size_t WS_CTL = 0, CTL_ZERO_BYTES = 1 * MiB;
constexpr size_t WS_MOD = 1 * MiB;
constexpr size_t WS_KPART = 2 * MiB;
constexpr size_t WS_W = 4 * MiB;
constexpr size_t W_LAYER = 23 * MiB, WO_IN = 0, WO_OUT = 5 * MiB, WO_1 = 7 * MiB, WO_2 = 15 * MiB;
constexpr size_t WS_H = 96 * MiB;
constexpr size_t WS_Y = 128 * MiB;
constexpr size_t WS_PROJ = 192 * MiB;
constexpr size_t WS_ATT = 264 * MiB;
constexpr size_t WS_U = 192 * MiB;
constexpr size_t WS_END = 320 * MiB;
static_assert(WS_W + DEPTH * W_LAYER <= WS_H && WS_ATT + (size_t)M * D * 2 <= WS_END && WS_U + (size_t)M * FF * 2 <= WS_END, "d_ws map");
constexpr int CW_BAR = 4096;
constexpr int RING_OFF = 0, RING_BYTES = 131072;
constexpr int LDSCTL_OFF = RING_BYTES, MISC_OFF = LDSCTL_OFF + 320;
constexpr int LDS_BYTES = 147456;
static_assert(att::L_END <= RING_BYTES, "attention scratch inside the ring region");

#define GAS __attribute__((address_space(1)))
#define LAS __attribute__((address_space(3)))
typedef unsigned v4u __attribute__((ext_vector_type(4)));
typedef float f32x4 __attribute__((ext_vector_type(4)));
typedef GAS unsigned gu32;
#define RLX_AGENT __ATOMIC_RELAXED, __HIP_MEMORY_SCOPE_AGENT
#define LDS_WAIT() asm volatile("s_waitcnt lgkmcnt(0)" ::: "memory")

#define XB_TMO      128
#define XB_XCNT(j)  (256  + 64 * (j))
#define XB_XSUB(j)  (1280 + 64 * (j))
#define XB_XGEN(j)  (2304 + 64 * (j))
#define XB_TOP      3328
#define XB_TOPGEN   3392
#define XCD_BAR_WORDS 3456
#define XB_SPIN_CAP (1u << 18)

__device__ __forceinline__ unsigned xb_ld(unsigned* p)              { return __hip_atomic_load(p, __ATOMIC_RELAXED, __HIP_MEMORY_SCOPE_AGENT); }
__device__ __forceinline__ unsigned xb_add(unsigned* p, unsigned v) { return __hip_atomic_fetch_add(p, v, __ATOMIC_RELAXED, __HIP_MEMORY_SCOPE_AGENT); }
__device__ __forceinline__ unsigned xb_xcc_id() { return (unsigned)__builtin_amdgcn_s_getreg((3 << 11) | 20) & 0xFu; }
#define XB_SPIN(cond, bar) do { unsigned _sp = 0; while (cond) { __builtin_amdgcn_s_sleep(1); \
    if ((++_sp & 255u) == 0u) { if (xb_ld(&(bar)[XB_TMO])) break; if (_sp > XB_SPIN_CAP) { atomicAdd(&(bar)[XB_TMO], 1u); break; } } } } while (0)

struct XcdBarrier {
    unsigned* bar; unsigned x;
    volatile LAS unsigned* st;
};

__device__ __forceinline__ XcdBarrier xcd_barrier_post(unsigned* bar, volatile LAS unsigned* st) {
    XcdBarrier b; b.bar = bar; b.x = xb_xcc_id(); b.st = st;
    if (threadIdx.x == 0) (void)xb_add(&bar[XB_XCNT(b.x)], 1u);
    return b;
}
__device__ __forceinline__ void xcd_barrier_complete(unsigned* bar, unsigned x, unsigned& nloc, unsigned& nx) {
    const unsigned G = gridDim.x * gridDim.y * gridDim.z;
    unsigned sum, cnt, mine, sp = 0u;
    for (;;) {
        sum = 0u; cnt = 0u; mine = 0u;
#pragma unroll
        for (unsigned j = 0; j < 16; ++j) { const unsigned c = xb_ld(&bar[XB_XCNT(j)]); sum += c; cnt += (c > 0u) ? 1u : 0u; mine = (j == x) ? c : mine; }
        if (sum == G) break;
        __builtin_amdgcn_s_sleep(1);
        if ((++sp & 255u) == 0u) { if (xb_ld(&bar[XB_TMO])) break; if (sp > XB_SPIN_CAP) { atomicAdd(&bar[XB_TMO], 1u); break; } }
    }
    nloc = mine > 0u ? mine : 1u; nx = cnt > 0u ? cnt : 1u;
}

__device__ __forceinline__ void xcd_barrier(const XcdBarrier& b) {
    asm volatile("s_waitcnt vmcnt(0)" ::: "memory");
    __syncthreads();
    if (threadIdx.x == 0) {
        unsigned* bar = b.bar;
        __builtin_amdgcn_s_waitcnt(0);
        unsigned nloc = b.st[0], nx = b.st[1];
        if (nloc == 0u) { xcd_barrier_complete(bar, b.x, nloc, nx); b.st[0] = nloc; b.st[1] = nx; }
        const unsigned old = xb_add(&bar[XB_XSUB(b.x)], 1u);
        const unsigned gen = old / nloc;
        if (old + 1u == (gen + 1u) * nloc) {
            __builtin_amdgcn_fence(__ATOMIC_RELEASE, "agent");
            asm volatile("s_waitcnt vmcnt(0)" ::: "memory");
            const unsigned og = xb_add(&bar[XB_TOP], 1u);
            const unsigned tg = og / nx;
            if (og + 1u == (tg + 1u) * nx) xb_add(&bar[XB_TOPGEN], 1u);
            else XB_SPIN(xb_ld(&bar[XB_TOPGEN]) == tg, bar);
            __builtin_amdgcn_fence(__ATOMIC_ACQUIRE, "agent");
            xb_add(&bar[XB_XGEN(b.x)], 1u);
            asm volatile("s_waitcnt vmcnt(0)" ::: "memory");
        } else {
            XB_SPIN(xb_ld(&bar[XB_XGEN(b.x)]) == gen, bar);
            __builtin_amdgcn_fence(__ATOMIC_ACQUIRE, "agent");
            asm volatile("s_waitcnt vmcnt(0)" ::: "memory");
        }
    }
    __syncthreads();
}
struct Frame {
    LAS unsigned char* lds;
    int tid, lane, wave, vcu, G;
};
__device__ __forceinline__ float wave_sum(float v) {
#pragma unroll
    for (int o = 1; o < 64; o <<= 1) v += __shfl_xor(v, o);
    return v;
}
__device__ __forceinline__ void p0_transpose_item(const float* W, int K, int N, f16_t* WT, LAS float* scr, int item, int lane) {
    const int nblk = N / 32, kb = item / nblk, nb = item % nblk, k0 = 64 * kb, n0 = 32 * nb;
#pragma unroll 8
    for (int i = 0; i < 32; ++i) { const int kk = 2 * i + (lane >> 5); scr[kk * 33 + (lane & 31)] = W[(size_t)(k0 + kk) * N + n0 + (lane & 31)]; }
    LDS_WAIT(); asm volatile("" ::: "memory");
    const int c = lane & 7;
#pragma unroll
    for (int j = 0; j < 4; ++j) { const int n = (lane >> 3) + 8 * j; const LAS float* s = scr + (8 * c) * 33 + n;
        v4u o; o.x = pk_f16(s[0 * 33], s[1 * 33]); o.y = pk_f16(s[2 * 33], s[3 * 33]); o.z = pk_f16(s[4 * 33], s[5 * 33]); o.w = pk_f16(s[6 * 33], s[7 * 33]);
        *(GAS v4u*)(WT + (size_t)(n0 + n) * K + k0 + 8 * c) = o; }
    LDS_WAIT(); asm volatile("" ::: "memory");
}
__device__ __forceinline__ void p0_prologue(Frame& F, const float* c, const float* w_ada, const float* b_ada, float* mod,
                                            const float* w_in, const float* w_out, const float* w1, const float* w2, unsigned char* wsw) {
    LAS float* cact = (LAS float*)(F.lds + RING_OFF);
    LAS float* red = (LAS float*)(F.lds + RING_OFF + 32768);
    for (int i = F.tid; i < BATCH * D; i += NWAVES * 64) { const float v = c[i]; cact[i] = v / (1.0f + expf(-v)); }
    __syncthreads();
    constexpr int NMOD = DEPTH * (6 * D / 64);
    for (int it = F.vcu; it < NMOD; it += F.G) {
        const int l = it / 96, cb = it % 96;
        const float* wp = w_ada + ((size_t)l * D + F.wave * 128) * (6 * D) + cb * 64 + F.lane;
        float acc[8];
#pragma unroll
        for (int b = 0; b < 8; ++b) acc[b] = 0.f;
        for (int k4 = 0; k4 < 128; k4 += 4) {
            float w[4];
#pragma unroll
            for (int j = 0; j < 4; ++j) w[j] = wp[(size_t)(k4 + j) * (6 * D)];
#pragma unroll
            for (int b = 0; b < 8; ++b) { const f32x4 cv = *(const LAS f32x4*)(cact + b * D + F.wave * 128 + k4); acc[b] += cv[0] * w[0] + cv[1] * w[1] + cv[2] * w[2] + cv[3] * w[3]; }
        }
#pragma unroll
        for (int b = 0; b < 8; ++b) red[(F.wave * 8 + b) * 64 + F.lane] = acc[b];
        __syncthreads();
        { const int b = F.tid >> 6, col = F.tid & 63; float s = 0.f;
#pragma unroll
          for (int w = 0; w < 8; ++w) s += red[(w * 8 + b) * 64 + col];
          mod[((size_t)l * BATCH + b) * (6 * D) + cb * 64 + col] = s + b_ada[(size_t)l * 6 * D + cb * 64 + col]; }
        __syncthreads();
    }
    __syncthreads();
    LAS float* scr = (LAS float*)(F.lds + RING_OFF + F.wave * 16384);
    const int gw = F.vcu * NWAVES + F.wave, NGW = F.G * NWAVES;
    constexpr int I_IN = (D / 64) * (DIN / 32), I_OUT = (D / 64) * (D / 32), I_1 = (D / 64) * (FF / 32), I_2 = (FF / 64) * (D / 32), I_L = I_IN + I_OUT + I_1 + I_2;
    for (int it = gw; it < DEPTH * I_L; it += NGW) {
        const int l = it / I_L; int r = it - l * I_L;
        unsigned char* wl = wsw + (size_t)l * W_LAYER;
        if (r < I_IN) { p0_transpose_item(w_in + (size_t)l * D * DIN, D, DIN, (f16_t*)(wl + WO_IN), scr, r, F.lane); continue; } r -= I_IN;
        if (r < I_OUT) { p0_transpose_item(w_out + (size_t)l * D * D, D, D, (f16_t*)(wl + WO_OUT), scr, r, F.lane); continue; } r -= I_OUT;
        if (r < I_1) { p0_transpose_item(w1 + (size_t)l * D * FF, D, FF, (f16_t*)(wl + WO_1), scr, r, F.lane); continue; } r -= I_1;
        p0_transpose_item(w2 + (size_t)l * FF * D, FF, D, (f16_t*)(wl + WO_2), scr, r, F.lane);
    }
}
__device__ __forceinline__ void thin_phase(Frame& F, const float* xin, const float* y, const float* gate, const float* gainY, const float* gainH, const float* sc, const float* sh, float* xout, f16_t* h) {
    const int gw = F.vcu * NWAVES + F.wave, NGW = F.G * NWAVES;
    for (int rg = gw; rg < M / 8; rg += NGW) {
        const int b = (rg * 8) / SEQ;
        f32x4 A[4], Bv[4], Cv[4];
#pragma unroll
        for (int j = 0; j < 4; ++j) { const int col = 4 * F.lane + 256 * j;
            if (y) A[j] = *(const f32x4*)(gate + (size_t)b * 6 * D + col) * *(const f32x4*)(gainY + col); else A[j] = (f32x4){0.f, 0.f, 0.f, 0.f};
            if (h) { Bv[j] = *(const f32x4*)(gainH + col) * (*(const f32x4*)(sc + (size_t)b * 6 * D + col) + 1.0f); Cv[j] = *(const f32x4*)(sh + (size_t)b * 6 * D + col); }
            else { Bv[j] = (f32x4){0.f, 0.f, 0.f, 0.f}; Cv[j] = Bv[j]; } }
        for (int r = 0; r < 8; ++r) {
            const size_t m = (size_t)rg * 8 + r;
            f32x4 xv[4];
#pragma unroll
            for (int j = 0; j < 4; ++j) xv[j] = *(const f32x4*)(xin + m * D + 4 * F.lane + 256 * j);
            if (y) {
                f32x4 yv[4]; float ss = 0.f;
#pragma unroll
                for (int j = 0; j < 4; ++j) { yv[j] = *(const f32x4*)(y + m * D + 4 * F.lane + 256 * j); ss += (yv[j].x * yv[j].x + yv[j].y * yv[j].y) + (yv[j].z * yv[j].z + yv[j].w * yv[j].w); }
                const float rstd = 1.0f / sqrtf(wave_sum(ss) * (1.0f / D) + EPS);
#pragma unroll
                for (int j = 0; j < 4; ++j) xv[j] += yv[j] * rstd * A[j];
            }
#pragma unroll
            for (int j = 0; j < 4; ++j) *(f32x4*)(xout + m * D + 4 * F.lane + 256 * j) = xv[j];
            if (h) {
                float ss = 0.f;
#pragma unroll
                for (int j = 0; j < 4; ++j) ss += (xv[j].x * xv[j].x + xv[j].y * xv[j].y) + (xv[j].z * xv[j].z + xv[j].w * xv[j].w);
                const float rstd = 1.0f / sqrtf(wave_sum(ss) * (1.0f / D) + EPS);
#pragma unroll
                for (int j = 0; j < 4; ++j) { const f32x4 o = xv[j] * rstd * Bv[j] + Cv[j];
                    unsigned long long w = (unsigned long long)pk_f16(o.x, o.y) | ((unsigned long long)pk_f16(o.z, o.w) << 32);
                    *(unsigned long long*)(h + m * D + 4 * F.lane + 256 * j) = w; }
            }
        }
    }
}

constexpr int NPH = 2 + 7 * DEPTH;
struct Args { const float* in[13]; float* out; unsigned char* ws; int ph_lo, ph_hi; };
__global__ void __launch_bounds__(NWAVES * 64, 2) fwd_kernel(Args args) {
    extern __shared__ __attribute__((aligned(16))) unsigned char lds[];
    Frame F;
    F.lds = (LAS unsigned char*)lds;
    volatile LAS unsigned* MISC = (volatile LAS unsigned*)(F.lds + MISC_OFF);
    F.tid = threadIdx.x; F.lane = F.tid & 63; F.wave = __builtin_amdgcn_readfirstlane(F.tid >> 6);
    F.G = gridDim.x; { const int bx = blockIdx.x; F.vcu = (F.G % 8 == 0) ? (bx % 8) * (F.G / 8) + bx / 8 : bx; }
    unsigned char* ws = args.ws;
    gu32* ctl = (gu32*)(ws + WS_CTL);
    const float* x_in = args.in[0]; const float* c_in = args.in[1]; const float* w_in = args.in[2]; const float* w_out = args.in[3]; const float* sinks = args.in[4];
    const float* rel_bias = args.in[5]; const float* w_ada = args.in[6]; const float* b_ada = args.in[7]; const float* gains = args.in[8];
    const float* w1 = args.in[9]; const float* b1 = args.in[10]; const float* w2 = args.in[11]; const float* b2 = args.in[12];
    float* xres = args.out;
    float* mod = (float*)(ws + WS_MOD); float* kpart = (float*)(ws + WS_KPART);
    f16_t* HB = (f16_t*)(ws + WS_H); float* YB = (float*)(ws + WS_Y); f16_t* PROJ = (f16_t*)(ws + WS_PROJ); f16_t* ATT = (f16_t*)(ws + WS_ATT); f16_t* UB = (f16_t*)(ws + WS_U);
    for (int u = F.tid; u < (LDS_BYTES - LDSCTL_OFF) / 4; u += NWAVES * 64) ((LAS unsigned*)(F.lds + LDSCTL_OFF))[u] = 0u;
    __syncthreads();
    XcdBarrier bar; bar.bar = (unsigned*)(ctl + CW_BAR); bar.x = 0; bar.st = nullptr;
    if (!MK_PER_PHASE) bar = xcd_barrier_post((unsigned*)(ctl + CW_BAR), MISC + 8);
    const int lo = args.ph_lo, hi = args.ph_hi;
#define IN(k) (lo <= (k) && (k) < hi)
#define SEAM(k) do { if (IN(k) && IN((k) + 1)) xcd_barrier(bar); } while (0)

    if (IN(0)) { p0_prologue(F, c_in, w_ada, b_ada, mod, w_in, w_out, w1, w2, ws + WS_W); SEAM(0); }

    for (int l = 0; l < DEPTH; ++l) {
        const int pb = 1 + 7 * l;
        { int t_ = threadIdx.x; asm volatile("" : "+v"(t_)); F.tid = t_; F.lane = t_ & 63; }
        const float* modl = mod + (size_t)l * BATCH * 6 * D;
        const float* gl = gains + (size_t)l * 4 * D;
        unsigned char* wl = ws + WS_W + (size_t)l * W_LAYER;
        if (IN(pb + 0)) {
            if (l == 0) thin_phase(F, x_in, nullptr, nullptr, nullptr, gl, modl + D, modl, xres, HB);
            else thin_phase(F, xres, YB, modl - (size_t)BATCH * 6 * D + 5 * D, gl - 4 * D + 3 * D, gl, modl + D, modl, xres, HB);
            SEAM(pb + 0);
        }
        if (IN(pb + 1)) {
            pg8::Gemm g{HB, (const f16_t*)(wl + WO_IN), M, DIN, D}; pg8::StaticOrder S; S.init(M, DIN, F.G, (int)blockIdx.x);
            pg8::EpiProj E{PROJ, kpart, att::C2};
            pg8::gemm_phase<pg8::EpiProj, pg8::StaticOrder, true, true>(F.lds + RING_OFF, g, S, E);
            SEAM(pb + 1);
        }
        if (IN(pb + 2)) {
            for (int pi = F.vcu; pi < 256; pi += F.G) { const int bh = pi >> 2, s = pi & 3;
                att::moba_unit(bh >> 3, bh & 7, 7 - s, PROJ, ATT, kpart, rel_bias, F.lds + RING_OFF, F.tid, F.wave, F.lane);
                att::moba_unit(bh >> 3, bh & 7, s, PROJ, ATT, kpart, rel_bias, F.lds + RING_OFF, F.tid, F.wave, F.lane); }
            for (int u = F.vcu; u < 512; u += F.G)
                att::swa_unit(u >> 6, (u >> 5) & 1, u & 31, PROJ, ATT, sinks + l * 8, rel_bias, F.lds + RING_OFF, F.tid, F.wave, F.lane);
            SEAM(pb + 2);
        }
        if (IN(pb + 3)) {
            pg8::Gemm g{ATT, (const f16_t*)(wl + WO_OUT), M, D, D}; pg8::StaticOrder S; S.init(M, D, F.G, (int)blockIdx.x);
            pg8::EpiF32 E{YB, D, nullptr};
            pg8::gemm_phase<pg8::EpiF32, pg8::StaticOrder, true, true>(F.lds + RING_OFF, g, S, E);
            SEAM(pb + 3);
        }
        if (IN(pb + 4)) { thin_phase(F, xres, YB, modl + 2 * D, gl + D, gl + 2 * D, modl + 4 * D, modl + 3 * D, xres, HB); SEAM(pb + 4); }
        if (IN(pb + 5)) {
            pg8::Gemm g{HB, (const f16_t*)(wl + WO_1), M, FF, D}; pg8::StaticOrder S; S.init(M, FF, F.G, (int)blockIdx.x);
            pg8::EpiSqRelu E{UB, FF, b1 + (size_t)l * FF};
            pg8::gemm_phase<pg8::EpiSqRelu, pg8::StaticOrder, true, true>(F.lds + RING_OFF, g, S, E);
            SEAM(pb + 5);
        }
        if (IN(pb + 6)) {
            pg8::Gemm g{UB, (const f16_t*)(wl + WO_2), M, D, FF}; pg8::StaticOrder S; S.init(M, D, F.G, (int)blockIdx.x);
            pg8::EpiF32 E{YB, D, b2 + (size_t)l * D};
            pg8::gemm_phase<pg8::EpiF32, pg8::StaticOrder, true, true>(F.lds + RING_OFF, g, S, E);
            SEAM(pb + 6);
        }
    }
    if (IN(NPH - 1)) {
        const float* modl = mod + (size_t)(DEPTH - 1) * BATCH * 6 * D; const float* gl = gains + (size_t)(DEPTH - 1) * 4 * D;
        thin_phase(F, xres, YB, modl + 5 * D, gl + 3 * D, nullptr, nullptr, nullptr, xres, nullptr);
    }
#undef IN
#undef SEAM
}

extern "C" void kernel_launch(void* const* d_in, const int* in_sizes, int n_in, void* d_out, int out_size, void* d_ws, size_t ws_size, hipStream_t stream) {
    static int grid = 0;
    if (grid == 0) {
        if (n_in != 13 || in_sizes[0] != M * D || out_size != M * D || ws_size < WS_END) { fprintf(stderr, "kernel_launch: unexpected shapes (n_in %d, in0 %d, out %d, ws %zu); nothing launched\n", n_in, n_in > 0 ? in_sizes[0] : -1, out_size, ws_size); grid = -1; return; }
        int dev = 0, cus = 0, per_cu = 0;
        if (hipGetDevice(&dev) != hipSuccess || hipDeviceGetAttribute(&cus, hipDeviceAttributeMultiprocessorCount, dev) != hipSuccess) { fprintf(stderr, "kernel_launch: device query failed\n"); grid = -1; return; }
        if (hipFuncSetAttribute((const void*)fwd_kernel, hipFuncAttributeMaxDynamicSharedMemorySize, LDS_BYTES) != hipSuccess) { fprintf(stderr, "kernel_launch: hipFuncSetAttribute failed\n"); grid = -1; return; }
        if (hipOccupancyMaxActiveBlocksPerMultiprocessor(&per_cu, (const void*)fwd_kernel, NWAVES * 64, LDS_BYTES) != hipSuccess || per_cu < 1)
            fprintf(stderr, "kernel_launch: note: occupancy query reports %d workgroups per CU\n", per_cu);
        (void)hipGetLastError();
        grid = cus;
    }
    if (grid < 0) return;
    if (hipMemsetAsync((char*)d_ws + WS_CTL, 0, CTL_ZERO_BYTES, stream) != hipSuccess) { fprintf(stderr, "kernel_launch: memset failed\n"); return; }
    Args a{};
    for (int i = 0; i < 13; ++i) a.in[i] = (const float*)d_in[i];
    a.out = (float*)d_out; a.ws = (unsigned char*)d_ws;
#if MK_PER_PHASE
    for (int p = 0; p < NPH; ++p) { a.ph_lo = p; a.ph_hi = p + 1; hipLaunchKernelGGL(fwd_kernel, dim3(grid), dim3(NWAVES * 64), LDS_BYTES, stream, a); }
#else
    a.ph_lo = 0; a.ph_hi = NPH;
    hipLaunchKernelGGL(fwd_kernel, dim3(grid), dim3(NWAVES * 64), LDS_BYTES, stream, a);
#endif
    const hipError_t le = hipPeekAtLastError();
    if (le != hipSuccess) fprintf(stderr, "kernel_launch: launch failed: %s\n", hipGetErrorName(le));
}
```

```cpp
#include <hip/hip_runtime.h>
#include <cstdio>
#include <cstdint>
#include <cmath>

#ifndef MK_PER_PHASE
#define MK_PER_PHASE 0
#endif

typedef _Float16 f16x8 __attribute__((ext_vector_type(8)));
typedef _Float16 f16x2 __attribute__((ext_vector_type(2)));
typedef unsigned short f16_t;
__device__ __forceinline__ unsigned pk_f16(float lo, float hi) { f16x2 v = {(_Float16)lo, (_Float16)hi}; return __builtin_bit_cast(unsigned, v); }

namespace pg8 {
#define PG8_LAS __attribute__((address_space(3)))
typedef unsigned short bf16_t;

typedef float f32x4 __attribute__((ext_vector_type(4)));
typedef unsigned u32x4 __attribute__((ext_vector_type(4)));
constexpr int BM = 256, BK = 64, HALF = 128, HTB = HALF * BK * 2  , STAGE_BYTES = 8 * HTB, NXCD = 8, WGM = 8;

__host__ __device__ __forceinline__ int lds_byte(int r, int c) { const int st = (r >> 4) * 2 + (c >> 5), rr = r & 15, cc = c & 31, ob = rr * 64 + cc * 2; return st * 1024 + (ob ^ (((ob >> 9) & 1) << 5)); }
__host__ __device__ __forceinline__ void stage_rc(int b, int& R, int& C) { const int st = b / 1024, sb = b % 1024, swz = sb ^ (((sb >> 9) & 1) << 5); R = (st >> 1) * 16 + swz / 64; C = (st & 1) * 32 + (swz % 64) / 2; }
__host__ __device__ __forceinline__ int perm32(int rho) { const int n = rho >> 4, i = rho & 15; return 8 * (i >> 2) + 4 * n + (i & 3); }

struct Unit { int pm, pn; };
struct Gemm { const bf16_t* A; const bf16_t* Bt; int M, N, K; };

struct StaticOrder {
    int nM, nN, nwg, G, c;
    __host__ __device__ void init(int M, int N, int G_, int c_) { nM = M / BM; nN = N / BM; nwg = nM * nN; G = G_; c = c_; }
    __host__ __device__ bool next(int i, Unit& u) const {
        const long L = (long)i * G + c; if (L >= nwg) return false;
        int wgid = (int)L; { const int q = nwg / NXCD, r = nwg % NXCD, xcd = wgid % NXCD, off = wgid / NXCD; wgid = (xcd < r ? xcd * (q + 1) : r * (q + 1) + (xcd - r) * q) + off; }
        const int nig = WGM * nN, gid = wgid / nig, fm = gid * WGM, gsz = (nM - fm) < WGM ? (nM - fm) : WGM;
        u.pm = fm + ((wgid % nig) % gsz); u.pn = (wgid % nig) / gsz; return true;
    }
    __device__ __forceinline__ void a_ready(const Unit&) const {}
    __device__ __forceinline__ void done(const Unit&) const {}
};

struct EpiProj {
    static constexpr bool PERM = true, AFTER_DRAIN = false;
    bf16_t* O; float* kpart; float qscale;
    __device__ __forceinline__ void operator()(const f32x4 (&acc)[2][2][4][2], const Unit& u, int wr, int wc, int fr, int fq) const {
        constexpr int ldc = 2304;
        const int row0 = u.pm * BM + wr * 64 + fr, colt = u.pn * BM, col0 = colt + wc * 32 + 8 * fq;
        const float sc = (u.pn < 2 || (u.pn >= 6 && u.pn < 8)) ? qscale : 1.f;
#pragma unroll
        for (int ai = 0; ai < 2; ++ai)
#pragma unroll
            for (int m = 0; m < 4; ++m) { bf16_t* rowp = O + (size_t)(row0 + ai * HALF + m * 16) * ldc + col0;
#pragma unroll
                for (int bj = 0; bj < 2; ++bj) { const f32x4 v0 = acc[ai][bj][m][0] * sc, v1 = acc[ai][bj][m][1] * sc;
                    u32x4 w; w.x = pk_f16(v0[0], v0[1]); w.y = pk_f16(v0[2], v0[3]); w.z = pk_f16(v1[0], v1[1]); w.w = pk_f16(v1[2], v1[3]);
                    *(u32x4*)(rowp + bj * HALF) = w; } }
        if (u.pn == 2 || u.pn == 3) {
#pragma unroll
            for (int bj = 0; bj < 2; ++bj) {
                f32x4 s0 = {0.f, 0.f, 0.f, 0.f}, s1 = {0.f, 0.f, 0.f, 0.f};
#pragma unroll
                for (int ai = 0; ai < 2; ++ai)
#pragma unroll
                    for (int m = 0; m < 4; ++m) { s0 += acc[ai][bj][m][0]; s1 += acc[ai][bj][m][1]; }
#pragma unroll
                for (int o = 1; o < 16; o <<= 1) {
#pragma unroll
                    for (int i = 0; i < 4; ++i) { s0[i] += __shfl_xor(s0[i], o); s1[i] += __shfl_xor(s1[i], o); } }
                if (fr == 0) { float* kp = kpart + (size_t)(u.pm * 2 + wr) * 512 + (colt - 512) + bj * HALF + wc * 32 + 8 * fq; *(f32x4*)kp = s0; *(f32x4*)(kp + 4) = s1; }
            }
        }
    }
};
struct EpiSqRelu {
    static constexpr bool PERM = true, AFTER_DRAIN = false;
    bf16_t* O; int ldc; const float* bias;
    __device__ __forceinline__ void operator()(const f32x4 (&acc)[2][2][4][2], const Unit& u, int wr, int wc, int fr, int fq) const {
        const int row0 = u.pm * BM + wr * 64 + fr, col0 = u.pn * BM + wc * 32 + 8 * fq;
        f32x4 bv[2][2];
#pragma unroll
        for (int bj = 0; bj < 2; ++bj)
#pragma unroll
            for (int n = 0; n < 2; ++n) bv[bj][n] = *(const f32x4*)(bias + col0 + bj * HALF + 4 * n);
#pragma unroll
        for (int ai = 0; ai < 2; ++ai)
#pragma unroll
            for (int m = 0; m < 4; ++m) { bf16_t* rowp = O + (size_t)(row0 + ai * HALF + m * 16) * ldc + col0;
#pragma unroll
                for (int bj = 0; bj < 2; ++bj) { f32x4 v0 = acc[ai][bj][m][0] + bv[bj][0], v1 = acc[ai][bj][m][1] + bv[bj][1];
#pragma unroll
                    for (int i = 0; i < 4; ++i) { const float a = fmaxf(v0[i], 0.f), b = fmaxf(v1[i], 0.f); v0[i] = a * a; v1[i] = b * b; }
                    u32x4 w; w.x = pk_f16(v0[0], v0[1]); w.y = pk_f16(v0[2], v0[3]); w.z = pk_f16(v1[0], v1[1]); w.w = pk_f16(v1[2], v1[3]);
                    *(u32x4*)(rowp + bj * HALF) = w; } }
    }
};
struct EpiF32 {
    static constexpr bool PERM = false, AFTER_DRAIN = false;
    float* O; int ldc; const float* bias;
    __device__ __forceinline__ void operator()(const f32x4 (&acc)[2][2][4][2], const Unit& u, int wr, int wc, int fr, int fq) const {
        const int row0 = u.pm * BM + wr * 64 + fr, col0 = u.pn * BM + wc * 32 + 4 * fq;
        f32x4 bv[2][2];
#pragma unroll
        for (int bj = 0; bj < 2; ++bj)
#pragma unroll
            for (int n = 0; n < 2; ++n) bv[bj][n] = bias ? *(const f32x4*)(bias + col0 + bj * HALF + n * 16) : (f32x4){0.f, 0.f, 0.f, 0.f};
#pragma unroll
        for (int ai = 0; ai < 2; ++ai)
#pragma unroll
            for (int m = 0; m < 4; ++m) { float* rowp = O + (size_t)(row0 + ai * HALF + m * 16) * ldc + col0;
#pragma unroll
                for (int bj = 0; bj < 2; ++bj)
#pragma unroll
                    for (int n = 0; n < 2; ++n) *(f32x4*)(rowp + bj * HALF + n * 16) = acc[ai][bj][m][n] + bv[bj][n]; }
    }
};

struct EpiF16 {
    static constexpr bool PERM = true, AFTER_DRAIN = false;
    bf16_t* O; int ldc; const float* bias;
    __device__ __forceinline__ void operator()(const f32x4 (&acc)[2][2][4][2], const Unit& u, int wr, int wc, int fr, int fq) const {
        const int row0 = u.pm * BM + wr * 64 + fr, col0 = u.pn * BM + wc * 32 + 8 * fq;
        f32x4 bv[2][2];
#pragma unroll
        for (int bj = 0; bj < 2; ++bj)
#pragma unroll
            for (int n = 0; n < 2; ++n) bv[bj][n] = bias ? *(const f32x4*)(bias + col0 + bj * HALF + 4 * n) : (f32x4){0.f, 0.f, 0.f, 0.f};
#pragma unroll
        for (int ai = 0; ai < 2; ++ai)
#pragma unroll
            for (int m = 0; m < 4; ++m) { bf16_t* rowp = O + (size_t)(row0 + ai * HALF + m * 16) * ldc + col0;
#pragma unroll
                for (int bj = 0; bj < 2; ++bj) { const f32x4 v0 = acc[ai][bj][m][0] + bv[bj][0], v1 = acc[ai][bj][m][1] + bv[bj][1];
                    u32x4 w; w.x = pk_f16(v0[0], v0[1]); w.y = pk_f16(v0[2], v0[3]); w.z = pk_f16(v1[0], v1[1]); w.w = pk_f16(v1[2], v1[3]);
                    *(u32x4*)(rowp + bj * HALF) = w; } }
    }
};

template <class Epi, class Sched, bool ALIGN_EPI = false, bool SP2 = false>
__device__ __forceinline__ void gemm_phase(PG8_LAS unsigned char* lds, const Gemm g, const Sched& S, const Epi& E) {
    int tid_ = threadIdx.x; asm volatile("" : "+v"(tid_));
    const int tid = tid_, wid = __builtin_amdgcn_readfirstlane(tid >> 6), lane = tid & 63, wr = wid >> 2, wc = wid & 3, fr = lane & 15, fq = lane >> 4;
    const int K = g.K, nt = K / BK;
    unsigned voffA[2], voffB[2];
#pragma unroll
    for (int i = 0; i < 2; ++i) { int R, C; stage_rc(tid * 16 + i * 8192, R, C); const int Rb = Epi::PERM ? ((R & ~31) + perm32(R & 31)) : R;
        voffA[i] = (unsigned)(R * K + C) * 2u; voffB[i] = (unsigned)(Rb * K + C) * 2u; }
    const size_t kstep = (size_t)(BK * 2);
    const size_t hstep = (size_t)HALF * K * 2;
    const size_t tstep = 2 * hstep;
    const unsigned ldsw = (unsigned)wid * 1024u;
    const int aoff = lds_byte(wr * 64 + fr, fq * 8), boff = lds_byte(wc * 32 + fr, fq * 8);
#define PG8_SA(b, h) (((b) * 2 + (h)) * HTB)
#define PG8_SB(b, h) ((4 + (b) * 2 + (h)) * HTB)
#define PG8_STAGE(bufoff, gbase, voff) do { _Pragma("unroll") for (int _i = 0; _i < 2; ++_i) \
        __builtin_amdgcn_global_load_lds((const unsigned*)((const char*)(gbase) + (voff)[_i]), (PG8_LAS unsigned*)(lds + (bufoff) + ldsw + _i * 8192), 16, 0, 0); } while (0)
#define PG8_LDA(dst, b, h) do { _Pragma("unroll") for (int m = 0; m < 4; ++m) _Pragma("unroll") for (int k = 0; k < 2; ++k) dst[m][k] = *(const PG8_LAS f16x8*)(lds + PG8_SA(b, h) + aoff + m * 2048 + k * 1024); } while (0)
#define PG8_LDB(dst, b, h) do { _Pragma("unroll") for (int n = 0; n < 2; ++n) _Pragma("unroll") for (int k = 0; k < 2; ++k) dst[n][k] = *(const PG8_LAS f16x8*)(lds + PG8_SB(b, h) + boff + n * 2048 + k * 1024); } while (0)
#define PG8_MMA(ai, bj, At, Bt) do { __builtin_amdgcn_s_setprio(1); _Pragma("unroll") for (int m = 0; m < 4; ++m) _Pragma("unroll") for (int n = 0; n < 2; ++n) _Pragma("unroll") for (int k = 0; k < 2; ++k) \
        acc[ai][bj][m][n] = __builtin_amdgcn_mfma_f32_16x16x32_f16(Bt[n][k], At[m][k], acc[ai][bj][m][n], 0, 0, 0); __builtin_amdgcn_s_setprio(0); } while (0)
#define PG8_WAIT_V(n) asm volatile("s_waitcnt vmcnt(" #n ")" ::: "memory")
#define PG8_WAIT_L(n) asm volatile("s_waitcnt lgkmcnt(" #n ")" ::: "memory")
#define PG8_BAR __builtin_amdgcn_s_barrier()
#define PG8_SCHED __builtin_amdgcn_sched_barrier(0)
    Unit cur, nxt; int ui = 0;
    if (!S.next(0, cur)) return;
    f32x4 acc[2][2][4][2];
#pragma unroll
    for (int a = 0; a < 2; ++a)
#pragma unroll
        for (int b = 0; b < 2; ++b)
#pragma unroll
            for (int m = 0; m < 4; ++m)
#pragma unroll
                for (int n = 0; n < 2; ++n) acc[a][b][m][n] = (f32x4){0.f, 0.f, 0.f, 0.f};
    f16x8 At[4][2], B0[2][2], B1[2][2];
    const char* cA = (const char*)g.A + (size_t)cur.pm * tstep; const char* cB = (const char*)g.Bt + (size_t)cur.pn * tstep;
    S.a_ready(cur);
    if constexpr (SP2) {
        PG8_STAGE(PG8_SB(0, 0), cB, voffB); PG8_STAGE(PG8_SB(0, 1), cB + hstep, voffB); PG8_STAGE(PG8_SA(0, 0), cA, voffA); PG8_STAGE(PG8_SA(0, 1), cA + hstep, voffA);
        if (wr == 1) PG8_BAR;
        PG8_WAIT_V(2); PG8_BAR;
        PG8_STAGE(PG8_SB(1, 0), cB + kstep, voffB); PG8_STAGE(PG8_SA(1, 0), cA + kstep, voffA); PG8_STAGE(PG8_SB(1, 1), cB + hstep + kstep, voffB);
        PG8_WAIT_V(6); PG8_BAR;
    } else {
        PG8_STAGE(PG8_SB(0, 0), cB, voffB); PG8_STAGE(PG8_SA(0, 0), cA, voffA); PG8_STAGE(PG8_SB(0, 1), cB + hstep, voffB); PG8_STAGE(PG8_SA(0, 1), cA + hstep, voffA);
        if (wr == 1) PG8_BAR;
        PG8_WAIT_V(4); PG8_BAR;
        PG8_STAGE(PG8_SB(1, 0), cB + kstep, voffB); PG8_STAGE(PG8_SA(1, 0), cA + kstep, voffA); PG8_STAGE(PG8_SB(1, 1), cB + hstep + kstep, voffB);
        PG8_WAIT_V(6); PG8_BAR;
    }
    for (;;) {
        const bool has_next = S.next(ui + 1, nxt);
        const char* nA = has_next ? (const char*)g.A + (size_t)nxt.pm * tstep : cA; const char* nB = has_next ? (const char*)g.Bt + (size_t)nxt.pn * tstep : cB;
        for (int t = 0; t < nt; t += 2) {
            const bool last = (t == nt - 2);
            const char* a1 = cA + (size_t)(t + 1) * kstep;
            const char* a2 = last ? nA : cA + (size_t)(t + 2) * kstep; const char* b2 = last ? nB : cB + (size_t)(t + 2) * kstep;
            const char* a3 = a2 + kstep; const char* b3 = b2 + kstep;
            if (last && has_next) S.a_ready(nxt);
            if constexpr (SP2) {
            PG8_LDB(B0, 0, 0); PG8_LDB(B1, 0, 1); PG8_SCHED; PG8_LDA(At, 0, 0); PG8_STAGE(PG8_SA(1, 1), a1 + hstep, voffA);
            PG8_WAIT_V(8); PG8_WAIT_L(0); PG8_BAR; PG8_MMA(0, 0, At, B0); PG8_MMA(0, 1, At, B1); PG8_BAR; PG8_SCHED;
            PG8_LDA(At, 0, 1); PG8_STAGE(PG8_SB(0, 0), b2, voffB); PG8_STAGE(PG8_SB(0, 1), b2 + hstep, voffB); PG8_STAGE(PG8_SA(0, 0), a2, voffA);
            PG8_WAIT_V(8); PG8_WAIT_L(0); PG8_BAR; PG8_MMA(1, 0, At, B0); PG8_MMA(1, 1, At, B1); PG8_BAR; PG8_SCHED;
            PG8_LDB(B0, 1, 0); PG8_LDB(B1, 1, 1); PG8_SCHED; PG8_LDA(At, 1, 0); PG8_STAGE(PG8_SA(0, 1), a2 + hstep, voffA);
            PG8_WAIT_V(8); PG8_WAIT_L(0); PG8_BAR; PG8_MMA(0, 0, At, B0); PG8_MMA(0, 1, At, B1); PG8_BAR; PG8_SCHED;
            PG8_LDA(At, 1, 1); PG8_STAGE(PG8_SB(1, 0), b3, voffB); PG8_STAGE(PG8_SB(1, 1), b3 + hstep, voffB); PG8_STAGE(PG8_SA(1, 0), a3, voffA);
            PG8_WAIT_V(8); PG8_WAIT_L(0); PG8_BAR; PG8_MMA(1, 0, At, B0); PG8_MMA(1, 1, At, B1); PG8_BAR; PG8_SCHED;
            } else {
            PG8_LDB(B0, 0, 0); PG8_SCHED; PG8_LDA(At, 0, 0); PG8_STAGE(PG8_SA(1, 1), a1 + hstep, voffA);
            PG8_WAIT_L(8); PG8_BAR; PG8_WAIT_L(0); PG8_MMA(0, 0, At, B0); PG8_BAR; PG8_SCHED;
            PG8_LDB(B1, 0, 1); PG8_STAGE(PG8_SB(0, 0), b2, voffB);
            PG8_BAR; PG8_WAIT_L(0); PG8_MMA(0, 1, At, B1); PG8_BAR;
            PG8_LDA(At, 0, 1); PG8_STAGE(PG8_SA(0, 0), a2, voffA);
            PG8_BAR; PG8_WAIT_L(0); PG8_MMA(1, 0, At, B0); PG8_BAR; PG8_SCHED;
            PG8_STAGE(PG8_SB(0, 1), b2 + hstep, voffB);
            PG8_WAIT_V(6); PG8_BAR; PG8_MMA(1, 1, At, B1); PG8_BAR;
            PG8_LDB(B0, 1, 0); PG8_SCHED; PG8_LDA(At, 1, 0); PG8_STAGE(PG8_SA(0, 1), a2 + hstep, voffA);
            PG8_WAIT_L(8); PG8_BAR; PG8_WAIT_L(0); PG8_MMA(0, 0, At, B0); PG8_BAR; PG8_SCHED;
            PG8_LDB(B1, 1, 1); PG8_STAGE(PG8_SB(1, 0), b3, voffB);
            PG8_BAR; PG8_WAIT_L(0); PG8_MMA(0, 1, At, B1); PG8_BAR;
            PG8_LDA(At, 1, 1); PG8_STAGE(PG8_SA(1, 0), a3, voffA);
            PG8_BAR; PG8_WAIT_L(0); PG8_MMA(1, 0, At, B0); PG8_BAR; PG8_SCHED;
            PG8_STAGE(PG8_SB(1, 1), b3 + hstep, voffB);
            PG8_WAIT_V(6); PG8_BAR; PG8_MMA(1, 1, At, B1); PG8_BAR;
            }
        }
        if constexpr (ALIGN_EPI) { if (wr == 0) PG8_BAR; }
        if constexpr (!Epi::AFTER_DRAIN) { E(acc, cur, wr, wc, fr, fq); S.done(cur); }
        if (!has_next) break;
#pragma unroll
        for (int a = 0; a < 2; ++a)
#pragma unroll
            for (int b = 0; b < 2; ++b)
#pragma unroll
                for (int m = 0; m < 4; ++m)
#pragma unroll
                    for (int n = 0; n < 2; ++n) acc[a][b][m][n] = (f32x4){0.f, 0.f, 0.f, 0.f};
        cur = nxt; cA = nA; cB = nB; ++ui;
        if constexpr (ALIGN_EPI) { if (wr == 1) PG8_BAR; }
    }
    PG8_WAIT_V(0);
    if constexpr (!ALIGN_EPI) { if (wr == 0) PG8_BAR; }
    PG8_BAR;
    if constexpr (Epi::AFTER_DRAIN) { E.fused(acc, cur, wr, wc, fr, fq, lds, wid, lane); S.done(cur); }
#undef PG8_SA
#undef PG8_SB
#undef PG8_STAGE
#undef PG8_LDA
#undef PG8_LDB
#undef PG8_MMA
#undef PG8_WAIT_V
#undef PG8_WAIT_L
#undef PG8_BAR
#undef PG8_SCHED
}
}
namespace att {
#define ALAS __attribute__((address_space(3)))
typedef float f32x16 __attribute__((ext_vector_type(16)));
typedef float f32x4a __attribute__((ext_vector_type(4)));
typedef short v4i16_t __attribute__((ext_vector_type(4)));
typedef unsigned u32x4a __attribute__((ext_vector_type(4)));
typedef unsigned u32x2a __attribute__((ext_vector_type(2)));
constexpr int SEQ = 2048, PITCH = 2304, OPITCH = 1024;
constexpr int SLOTB = 8192, NSLOT = 3;
constexpr int TBL_N = 640;
constexpr int L_K = 0, L_V = NSLOT * SLOTB, L_TBL = 2 * NSLOT * SLOTB, L_KM = L_TBL + 4 * TBL_N * 4, L_END = L_KM + 8 * 64 * 4;
constexpr float LOG2E = 1.4426950408889634f, C2 = 0.125f * LOG2E;
__constant__ unsigned char T5B[128] = {0,1,2,3,4,5,6,7,8,9,10,11,12,13,14,15,16,16,16,17,17,18,18,18,19,19,19,20,20,20,20,21,21,21,21,22,22,22,22,22,23,23,23,23,23,23,24,24,24,24,24,24,
    25,25,25,25,25,25,25,26,26,26,26,26,26,26,26,27,27,27,27,27,27,27,27,27,27,28,28,28,28,28,28,28,28,28,28,29,29,29,29,29,29,29,29,29,29,29,29,30,30,30,30,30,30,30,30,30,30,30,30,30,30,
    31,31,31,31,31,31,31,31,31,31,31,31,31,31,31};
__device__ __forceinline__ void glds16(const void* gsrc, unsigned lds_dst) { unsigned keep;
    asm volatile("s_mov_b32 %0, m0\n\ts_mov_b32 m0, %2\n\ts_nop 0\n\tglobal_load_lds_dwordx4 %1, off\n\ts_mov_b32 m0, %0" : "=&s"(keep) : "v"(gsrc), "s"(lds_dst) : "memory"); }
#define ATT_WAIT_BAR(N) asm volatile("s_waitcnt vmcnt(" #N ") lgkmcnt(0)\n\ts_barrier" ::: "memory")
__device__ __forceinline__ float swap_max(float v) { auto rr = __builtin_amdgcn_permlane32_swap(__float_as_uint(v), __float_as_uint(v), false, false); return fmaxf(__uint_as_float(rr[0]), __uint_as_float(rr[1])); }
__device__ __forceinline__ float swap_sum(float v) { auto rr = __builtin_amdgcn_permlane32_swap(__float_as_uint(v), __float_as_uint(v), false, false); return __uint_as_float(rr[0]) + __uint_as_float(rr[1]); }

template <bool MOBA>
__device__ __forceinline__ void attn_core(const f16_t* Qrow, const f16_t* Kh, const f16_t* Vh, f16_t* Orow, ALAS unsigned char* shm, const ALAS float* tbl, const ALAS float* kmean,
                                          int qpos, int qw0, int idx, float c31, float sink2, int wid, int lane) {
    const int r32 = lane & 31, hi = lane >> 5;
    const unsigned lds0 = (unsigned)(uintptr_t)shm;
    f16x8 qr[4];
#pragma unroll
    for (int d0 = 0; d0 < 4; ++d0) qr[d0] = *(const f16x8*)(Qrow + d0 * 16 + hi * 8);
    const int NT = MOBA ? 4 * (idx + 1) : (idx + 1 < 3 ? idx + 1 : 3);
    const f16_t* ksrc = Kh + (size_t)lane * PITCH + wid * 8;
    const f16_t* vsrc = Vh + (size_t)(16 * (wid & 3) + (lane >> 2)) * PITCH + (wid >> 2) * 32 + (lane & 3) * 8;
    const unsigned kdst = lds0 + L_K + wid * 1024, vdst = lds0 + L_V + wid * 1024;
#define ATT_KT(i) (MOBA ? ((i) < 4 ? 4 * idx + (i) : 4 * (idx - 1 - (((i) - 4) >> 2)) + (((i) - 4) & 3)) : idx - (i))
#define ATT_DMA(i, slot) do { const int kt_ = ATT_KT(i); glds16(ksrc + (size_t)kt_ * 64 * PITCH, (unsigned)__builtin_amdgcn_readfirstlane(kdst + (slot) * SLOTB)); \
                              glds16(vsrc + (size_t)kt_ * 64 * PITCH, (unsigned)__builtin_amdgcn_readfirstlane(vdst + (slot) * SLOTB)); } while (0)
    ATT_DMA(0, 0);
    if (NT > 1) ATT_DMA(1, 1);
    unsigned selmask = 0u;
    if (MOBA && idx > 0) {
        if (idx <= 3) selmask = (1u << idx) - 1u;
        else {
            float g[7];
#pragma unroll
            for (int n = 0; n < 7; ++n) {
                float a = -INFINITY;
                if (n < idx) { a = 0.f;
#pragma unroll
                    for (int d0 = 0; d0 < 4; ++d0) { const f32x4a k0 = *(const ALAS f32x4a*)(kmean + n * 64 + d0 * 16 + hi * 8), k1 = *(const ALAS f32x4a*)(kmean + n * 64 + d0 * 16 + hi * 8 + 4);
                        a += (float)qr[d0][0] * k0[0] + (float)qr[d0][1] * k0[1] + (float)qr[d0][2] * k0[2] + (float)qr[d0][3] * k0[3]
                           + (float)qr[d0][4] * k1[0] + (float)qr[d0][5] * k1[1] + (float)qr[d0][6] * k1[2] + (float)qr[d0][7] * k1[3]; }
                    a = swap_sum(a); }
                g[n] = a; }
#pragma unroll
            for (int n = 0; n < 7; ++n) { int rank = 0;
#pragma unroll
                for (int m2 = 0; m2 < 7; ++m2) if (m2 != n) rank += (g[m2] > g[n] || (g[m2] == g[n] && m2 < n)) ? 1 : 0;
                if (n < idx && rank < 3) selmask |= 1u << n; }
        }
    }
    float mrun = -INFINITY, lrun = 0.f; f32x16 o0 = {}, o1 = {};
    const ALAS unsigned char* kp0 = shm + L_K + hi * 1024 + r32 * 16;
    const ALAS unsigned char* vp0 = shm + L_V + ((lane >> 4) & 1) * 32 + (lane & 3) * 8 + (4 * hi + ((lane & 15) >> 2)) * 64;
    for (int i = 0; i < NT; ++i) {
        if (i + 1 < NT) ATT_WAIT_BAR(2); else ATT_WAIT_BAR(0);
        if (i + 2 < NT) { const int sl = (i + 2) % NSLOT; ATT_DMA(i + 2, sl); }
        const int slot = (i % NSLOT) * SLOTB;
        const int k0 = ATT_KT(i) * 64;
        bool compute, near; float cinit;
        if (MOBA) {
            if (i < 4) { compute = (k0 <= qw0 + 31); near = true; cinit = 0.f; }
            else { const int n = idx - 1 - ((i - 4) >> 2); const bool sel = ((selmask >> n) & 1u) != 0u; compute = __any(sel) != 0; near = (qw0 - (k0 + 63) < 113);
                   cinit = sel ? (near ? 0.f : c31) : -INFINITY; }
        } else { compute = true; near = true; cinit = 0.f; }
        if (compute) {
            f32x16 p0, p1;
#pragma unroll
            for (int r = 0; r < 16; ++r) { p0[r] = cinit; p1[r] = cinit; }
            const ALAS unsigned char* kp = kp0 + slot;
#pragma unroll
            for (int d0 = 0; d0 < 4; ++d0) { const f16x8 b0 = *(const ALAS f16x8*)(kp + d0 * 2048), b1 = *(const ALAS f16x8*)(kp + d0 * 2048 + 512);
                p0 = __builtin_amdgcn_mfma_f32_32x32x16_f16(b0, qr[d0], p0, 0, 0, 0); p1 = __builtin_amdgcn_mfma_f32_32x32x16_f16(b1, qr[d0], p1, 0, 0, 0); }
            if (near) { const ALAS float* tb = tbl + (qpos - k0 - 4 * hi + 256 - 64);
#pragma unroll
                for (int r = 0; r < 16; ++r) { const int cr = (r & 3) + 8 * (r >> 2); p0[r] += tb[64 - cr]; p1[r] += tb[32 - cr]; } }
            float rm = p0[0];
#pragma unroll
            for (int r = 1; r < 16; ++r) rm = fmaxf(rm, p0[r]);
#pragma unroll
            for (int r = 0; r < 16; ++r) rm = fmaxf(rm, p1[r]);
            rm = swap_max(rm);
            const float mnew = fmaxf(mrun, rm), msafe = (mnew == -INFINITY) ? 0.f : mnew;
            const float alpha = __builtin_amdgcn_exp2f(mrun - msafe);
            float ls = 0.f;
#pragma unroll
            for (int r = 0; r < 16; ++r) { p0[r] = __builtin_amdgcn_exp2f(p0[r] - msafe); p1[r] = __builtin_amdgcn_exp2f(p1[r] - msafe); ls += p0[r] + p1[r]; }
            lrun = lrun * alpha + ls; mrun = mnew;
            if (__any(alpha != 1.0f)) {
#pragma unroll
                for (int r = 0; r < 16; ++r) { o0[r] *= alpha; o1[r] *= alpha; } }
            u32x4a pw[4];
#pragma unroll
            for (int j = 0; j < 4; ++j) { pw[0][j] = pk_f16(p0[2 * j], p0[2 * j + 1]); pw[1][j] = pk_f16(p0[8 + 2 * j], p0[8 + 2 * j + 1]);
                                          pw[2][j] = pk_f16(p1[2 * j], p1[2 * j + 1]); pw[3][j] = pk_f16(p1[8 + 2 * j], p1[8 + 2 * j + 1]); }
            const ALAS unsigned char* vp = vp0 + slot;
#pragma unroll
            for (int s = 0; s < 4; ++s) {
                const f16x8 pf = __builtin_bit_cast(f16x8, pw[s]);
#pragma unroll
                for (int d0 = 0; d0 < 2; ++d0) {
                    const v4i16_t lo = __builtin_amdgcn_ds_read_tr16_b64_v4i16((ALAS v4i16_t*)(vp + d0 * 4096 + s * 1024));
                    const v4i16_t hv = __builtin_amdgcn_ds_read_tr16_b64_v4i16((ALAS v4i16_t*)(vp + d0 * 4096 + s * 1024 + 512));
                    typedef short s16x8 __attribute__((ext_vector_type(8)));
                    const s16x8 vv = {lo[0], lo[1], lo[2], lo[3], hv[0], hv[1], hv[2], hv[3]};
                    const f16x8 vf = __builtin_bit_cast(f16x8, vv);
                    if (d0 == 0) o0 = __builtin_amdgcn_mfma_f32_32x32x16_f16(vf, pf, o0, 0, 0, 0); else o1 = __builtin_amdgcn_mfma_f32_32x32x16_f16(vf, pf, o1, 0, 0, 0);
                }
            }
        }
    }
    float lt = swap_sum(lrun);
    if (!MOBA) lt += __builtin_amdgcn_exp2f(sink2 - mrun);
    const float inv = 1.0f / lt;
#pragma unroll
    for (int g = 0; g < 4; ++g) {
        u32x2a w0, w1; w0.x = pk_f16(o0[4 * g] * inv, o0[4 * g + 1] * inv); w0.y = pk_f16(o0[4 * g + 2] * inv, o0[4 * g + 3] * inv);
        w1.x = pk_f16(o1[4 * g] * inv, o1[4 * g + 1] * inv); w1.y = pk_f16(o1[4 * g + 2] * inv, o1[4 * g + 3] * inv);
        *(u32x2a*)(Orow + 8 * g + 4 * hi) = w0; *(u32x2a*)(Orow + 32 + 8 * g + 4 * hi) = w1; }
    ATT_WAIT_BAR(0);
#undef ATT_KT
#undef ATT_DMA
}

__device__ __forceinline__ float tbl_entry(const float* rel_bias, int head, int i, bool moba) {
    const int dist = i - 256;
    if (dist < 0) return -INFINITY;
    if (dist >= 128) return moba ? rel_bias[31 * 16 + head] * LOG2E : -INFINITY;
    return rel_bias[(int)T5B[dist] * 16 + head] * LOG2E;
}
__device__ __forceinline__ void moba_unit(int b, int h, int qb, const f16_t* proj, f16_t* aout, const float* kpart, const float* rel_bias, ALAS unsigned char* shm, int tid, int wid, int lane) {
    ALAS float* tbl = (ALAS float*)(shm + L_TBL); ALAS float* km = (ALAS float*)(shm + L_KM);
    for (int i = tid; i < TBL_N; i += 512) tbl[i] = tbl_entry(rel_bias, h, i, true);
    for (int i = tid; i < qb * 64; i += 512) { const int n = i >> 6, d = i & 63; const float* kp = kpart + (size_t)((b * 8 + n) * 2) * 512 + h * 64 + d; km[i] = (kp[0] + kp[512]) * (1.0f / 256.0f); }
    ATT_WAIT_BAR(0);
    const size_t rowbase = (size_t)b * SEQ; const int qw0 = qb * 256 + wid * 32, qpos = qw0 + (lane & 31);
    const float c31 = rel_bias[31 * 16 + h] * LOG2E;
    attn_core<true>(proj + (rowbase + qpos) * PITCH + h * 64, proj + rowbase * PITCH + 512 + h * 64, proj + rowbase * PITCH + 1024 + h * 64, aout + (rowbase + qpos) * OPITCH + h * 64,
                    shm, tbl, km, qpos, qw0, qb, c31, 0.f, wid, lane);
}
__device__ __forceinline__ void swa_unit(int b, int kvh, int t, const f16_t* proj, f16_t* aout, const float* sinks, const float* rel_bias, ALAS unsigned char* shm, int tid, int wid, int lane) {
    ALAS float* tbl = (ALAS float*)(shm + L_TBL);
    for (int i = tid; i < 4 * TBL_N; i += 512) { const int g = i / TBL_N, e = i - g * TBL_N; tbl[i] = tbl_entry(rel_bias, 8 + 4 * kvh + g, e, false); }
    ATT_WAIT_BAR(0);
    const int g = wid >> 1, j = 4 * kvh + g;
    const size_t rowbase = (size_t)b * SEQ; const int qw0 = t * 64 + (wid & 1) * 32, qpos = qw0 + (lane & 31);
    attn_core<false>(proj + (rowbase + qpos) * PITCH + 1536 + j * 64, proj + rowbase * PITCH + 2048 + kvh * 64, proj + rowbase * PITCH + 2176 + kvh * 64, aout + (rowbase + qpos) * OPITCH + 512 + j * 64,
                     shm, tbl + g * TBL_N, nullptr, qpos, qw0, t, 0.f, sinks[j] * LOG2E, wid, lane);
}
#undef ATT_WAIT_BAR
}

constexpr int NWAVES = 8;
constexpr int BATCH = 8, SEQ = 2048, D = 1024, DEPTH = 4, DIN = 2304, FF = 4096, M = BATCH * SEQ;
constexpr float EPS = 1e-6f;
constexpr size_t MiB = 1u << 20;
constexpr size_t WS_CTL = 0, CTL_ZERO_BYTES = 1 * MiB;
constexpr size_t WS_MOD = 1 * MiB;
constexpr size_t WS_KPART = 2 * MiB;
constexpr size_t WS_W = 4 * MiB;
constexpr size_t W_LAYER = 23 * MiB, WO_IN = 0, WO_OUT = 5 * MiB, WO_1 = 7 * MiB, WO_2 = 15 * MiB;
constexpr size_t WS_H = 96 * MiB;
constexpr size_t WS_Y = 128 * MiB;
constexpr size_t WS_X = 160 * MiB;
constexpr size_t WS_PROJ = 192 * MiB;
constexpr size_t WS_ATT = 264 * MiB;
constexpr size_t WS_U = 192 * MiB;
constexpr size_t WS_END = 320 * MiB;
static_assert(WS_W + DEPTH * W_LAYER <= WS_H && WS_ATT + (size_t)M * D * 2 <= WS_END && WS_U + (size_t)M * FF * 2 <= WS_END, "d_ws map");
constexpr int CW_BAR = 4096;
constexpr int RING_OFF = 0, RING_BYTES = 131072;
constexpr int LDSCTL_OFF = RING_BYTES, MISC_OFF = LDSCTL_OFF + 320;
constexpr int LDS_BYTES = 147456;
static_assert(att::L_END <= RING_BYTES, "attention scratch inside the ring region");

#define GAS __attribute__((address_space(1)))
#define LAS __attribute__((address_space(3)))
typedef unsigned v4u __attribute__((ext_vector_type(4)));
typedef float f32x4 __attribute__((ext_vector_type(4)));
typedef GAS unsigned gu32;
#define RLX_AGENT __ATOMIC_RELAXED, __HIP_MEMORY_SCOPE_AGENT
#define LDS_WAIT() asm volatile("s_waitcnt lgkmcnt(0)" ::: "memory")

#define XB_TMO      128
#define XB_XCNT(j)  (256  + 64 * (j))
#define XB_XSUB(j)  (1280 + 64 * (j))
#define XB_XGEN(j)  (2304 + 64 * (j))
#define XB_TOP      3328
#define XB_TOPGEN   3392
#define XCD_BAR_WORDS 3456
#define XB_SPIN_CAP (1u << 18)

__device__ __forceinline__ unsigned xb_ld(unsigned* p)              { return __hip_atomic_load(p, __ATOMIC_RELAXED, __HIP_MEMORY_SCOPE_AGENT); }
__device__ __forceinline__ unsigned xb_add(unsigned* p, unsigned v) { return __hip_atomic_fetch_add(p, v, __ATOMIC_RELAXED, __HIP_MEMORY_SCOPE_AGENT); }
__device__ __forceinline__ unsigned xb_xcc_id() { return (unsigned)__builtin_amdgcn_s_getreg((3 << 11) | 20) & 0xFu; }
#define XB_SPIN(cond, bar) do { unsigned _sp = 0; while (cond) { __builtin_amdgcn_s_sleep(1); \
    if ((++_sp & 255u) == 0u) { if (xb_ld(&(bar)[XB_TMO])) break; if (_sp > XB_SPIN_CAP) { atomicAdd(&(bar)[XB_TMO], 1u); break; } } } } while (0)

struct XcdBarrier {
    unsigned* bar; unsigned x;
    volatile LAS unsigned* st;
};

__device__ __forceinline__ XcdBarrier xcd_barrier_post(unsigned* bar, volatile LAS unsigned* st) {
    XcdBarrier b; b.bar = bar; b.x = xb_xcc_id(); b.st = st;
    if (threadIdx.x == 0) (void)xb_add(&bar[XB_XCNT(b.x)], 1u);
    return b;
}
__device__ __forceinline__ void xcd_barrier_complete(unsigned* bar, unsigned x, unsigned& nloc, unsigned& nx) {
    const unsigned G = gridDim.x * gridDim.y * gridDim.z;
    unsigned sum, cnt, mine, sp = 0u;
    for (;;) {
        sum = 0u; cnt = 0u; mine = 0u;
#pragma unroll
        for (unsigned j = 0; j < 16; ++j) { const unsigned c = xb_ld(&bar[XB_XCNT(j)]); sum += c; cnt += (c > 0u) ? 1u : 0u; mine = (j == x) ? c : mine; }
        if (sum == G) break;
        __builtin_amdgcn_s_sleep(1);
        if ((++sp & 255u) == 0u) { if (xb_ld(&bar[XB_TMO])) break; if (sp > XB_SPIN_CAP) { atomicAdd(&bar[XB_TMO], 1u); break; } }
    }
    nloc = mine > 0u ? mine : 1u; nx = cnt > 0u ? cnt : 1u;
}

__device__ __forceinline__ void xcd_barrier(const XcdBarrier& b) {
    asm volatile("s_waitcnt vmcnt(0)" ::: "memory");
    __syncthreads();
    if (threadIdx.x == 0) {
        unsigned* bar = b.bar;
        __builtin_amdgcn_s_waitcnt(0);
        unsigned nloc = b.st[0], nx = b.st[1];
        if (nloc == 0u) { xcd_barrier_complete(bar, b.x, nloc, nx); b.st[0] = nloc; b.st[1] = nx; }
        const unsigned old = xb_add(&bar[XB_XSUB(b.x)], 1u);
        const unsigned gen = old / nloc;
        if (old + 1u == (gen + 1u) * nloc) {
            __builtin_amdgcn_fence(__ATOMIC_RELEASE, "agent");
            asm volatile("s_waitcnt vmcnt(0)" ::: "memory");
            const unsigned og = xb_add(&bar[XB_TOP], 1u);
            const unsigned tg = og / nx;
            if (og + 1u == (tg + 1u) * nx) xb_add(&bar[XB_TOPGEN], 1u);
            else XB_SPIN(xb_ld(&bar[XB_TOPGEN]) == tg, bar);
            __builtin_amdgcn_fence(__ATOMIC_ACQUIRE, "agent");
            xb_add(&bar[XB_XGEN(b.x)], 1u);
            asm volatile("s_waitcnt vmcnt(0)" ::: "memory");
        } else {
            XB_SPIN(xb_ld(&bar[XB_XGEN(b.x)]) == gen, bar);
            __builtin_amdgcn_fence(__ATOMIC_ACQUIRE, "agent");
            asm volatile("s_waitcnt vmcnt(0)" ::: "memory");
        }
    }
    __syncthreads();
}
struct Frame {
    LAS unsigned char* lds;
    int tid, lane, wave, vcu, G;
};
__device__ __forceinline__ float wave_sum(float v) {
#pragma unroll
    for (int o = 1; o < 64; o <<= 1) v += __shfl_xor(v, o);
    return v;
}
__device__ __forceinline__ void p0_transpose_item(const float* W, int K, int N, f16_t* WT, LAS float* scr, int item, int lane) {
    const int nblk = N / 32, kb = item / nblk, nb = item % nblk, k0 = 64 * kb, n0 = 32 * nb;
#pragma unroll 8
    for (int i = 0; i < 32; ++i) { const int kk = 2 * i + (lane >> 5); scr[kk * 33 + (lane & 31)] = W[(size_t)(k0 + kk) * N + n0 + (lane & 31)]; }
    LDS_WAIT(); asm volatile("" ::: "memory");
    const int c = lane & 7;
#pragma unroll
    for (int j = 0; j < 4; ++j) { const int n = (lane >> 3) + 8 * j; const LAS float* s = scr + (8 * c) * 33 + n;
        v4u o; o.x = pk_f16(s[0 * 33], s[1 * 33]); o.y = pk_f16(s[2 * 33], s[3 * 33]); o.z = pk_f16(s[4 * 33], s[5 * 33]); o.w = pk_f16(s[6 * 33], s[7 * 33]);
        *(GAS v4u*)(WT + (size_t)(n0 + n) * K + k0 + 8 * c) = o; }
    LDS_WAIT(); asm volatile("" ::: "memory");
}
__device__ __forceinline__ void p0_prologue(Frame& F, const float* c, const float* w_ada, const float* b_ada, float* mod,
                                            const float* w_in, const float* w_out, const float* w1, const float* w2, unsigned char* wsw) {
    LAS float* cact = (LAS float*)(F.lds + RING_OFF);
    LAS float* red = (LAS float*)(F.lds + RING_OFF + 32768);
    for (int i = F.tid; i < BATCH * D; i += NWAVES * 64) { const float v = c[i]; cact[i] = v / (1.0f + expf(-v)); }
    __syncthreads();
    constexpr int NMOD = DEPTH * (6 * D / 64);
    for (int it = F.vcu; it < NMOD; it += F.G) {
        const int l = it / 96, cb = it % 96;
        const float* wp = w_ada + ((size_t)l * D + F.wave * 128) * (6 * D) + cb * 64 + F.lane;
        float acc[8];
#pragma unroll
        for (int b = 0; b < 8; ++b) acc[b] = 0.f;
        for (int k4 = 0; k4 < 128; k4 += 4) {
            float w[4];
#pragma unroll
            for (int j = 0; j < 4; ++j) w[j] = wp[(size_t)(k4 + j) * (6 * D)];
#pragma unroll
            for (int b = 0; b < 8; ++b) { const f32x4 cv = *(const LAS f32x4*)(cact + b * D + F.wave * 128 + k4); acc[b] += cv[0] * w[0] + cv[1] * w[1] + cv[2] * w[2] + cv[3] * w[3]; }
        }
#pragma unroll
        for (int b = 0; b < 8; ++b) red[(F.wave * 8 + b) * 64 + F.lane] = acc[b];
        __syncthreads();
        { const int b = F.tid >> 6, col = F.tid & 63; float s = 0.f;
#pragma unroll
          for (int w = 0; w < 8; ++w) s += red[(w * 8 + b) * 64 + col];
          mod[((size_t)l * BATCH + b) * (6 * D) + cb * 64 + col] = s + b_ada[(size_t)l * 6 * D + cb * 64 + col]; }
        __syncthreads();
    }
    __syncthreads();
    LAS float* scr = (LAS float*)(F.lds + RING_OFF + F.wave * 16384);
    const int gw = F.vcu * NWAVES + F.wave, NGW = F.G * NWAVES;
    constexpr int I_IN = (D / 64) * (DIN / 32), I_OUT = (D / 64) * (D / 32), I_1 = (D / 64) * (FF / 32), I_2 = (FF / 64) * (D / 32), I_L = I_IN + I_OUT + I_1 + I_2;
    for (int it = gw; it < DEPTH * I_L; it += NGW) {
        const int l = it / I_L; int r = it - l * I_L;
        unsigned char* wl = wsw + (size_t)l * W_LAYER;
        if (r < I_IN) { p0_transpose_item(w_in + (size_t)l * D * DIN, D, DIN, (f16_t*)(wl + WO_IN), scr, r, F.lane); continue; } r -= I_IN;
        if (r < I_OUT) { p0_transpose_item(w_out + (size_t)l * D * D, D, D, (f16_t*)(wl + WO_OUT), scr, r, F.lane); continue; } r -= I_OUT;
        if (r < I_1) { p0_transpose_item(w1 + (size_t)l * D * FF, D, FF, (f16_t*)(wl + WO_1), scr, r, F.lane); continue; } r -= I_1;
        p0_transpose_item(w2 + (size_t)l * FF * D, FF, D, (f16_t*)(wl + WO_2), scr, r, F.lane);
    }
}
__device__ __forceinline__ void ld8(const float* p, float (&v)[8]) { const f32x4 a = *(const f32x4*)p, b = *(const f32x4*)(p + 4); v[0] = a.x; v[1] = a.y; v[2] = a.z; v[3] = a.w; v[4] = b.x; v[5] = b.y; v[6] = b.z; v[7] = b.w; }
__device__ __forceinline__ void ld8h(const f16_t* p, float (&v)[8]) { const f16x8 a = *(const f16x8*)p;
#pragma unroll
    for (int i = 0; i < 8; ++i) v[i] = (float)a[i]; }
__device__ __forceinline__ void st8h(f16_t* p, const float (&v)[8]) { v4u w; w.x = pk_f16(v[0], v[1]); w.y = pk_f16(v[2], v[3]); w.z = pk_f16(v[4], v[5]); w.w = pk_f16(v[6], v[7]); *(v4u*)p = w; }
template <bool XIN_F32, bool XOUT_F32, bool HAS_Y, bool HAS_H>
__device__ __forceinline__ void thin_phase(Frame& F, const void* xin, const f16_t* y, const float* gate, const float* gainY, const float* gainH, const float* sc, const float* sh, void* xout, f16_t* h) {
    const int gw = F.vcu * NWAVES + F.wave, NGW = F.G * NWAVES;
    for (int rg = gw; rg < M / 8; rg += NGW) {
        const int b = (rg * 8) / SEQ;
        float A[2][8], Bv[2][8], Cv[2][8];
#pragma unroll
        for (int j = 0; j < 2; ++j) { const int col = 8 * F.lane + 512 * j;
            if (HAS_Y) { float g_[8], n_[8]; ld8(gate + (size_t)b * 6 * D + col, g_); ld8(gainY + col, n_);
#pragma unroll
                for (int i = 0; i < 8; ++i) A[j][i] = g_[i] * n_[i]; }
            if (HAS_H) { float g_[8], s_[8]; ld8(gainH + col, g_); ld8(sc + (size_t)b * 6 * D + col, s_); ld8(sh + (size_t)b * 6 * D + col, Cv[j]);
#pragma unroll
                for (int i = 0; i < 8; ++i) Bv[j][i] = g_[i] * (1.0f + s_[i]); } }
        for (int r = 0; r < 8; ++r) {
            const size_t m = (size_t)rg * 8 + r;
            float xv[2][8];
#pragma unroll
            for (int j = 0; j < 2; ++j) { const size_t off = m * D + 8 * F.lane + 512 * j; if (XIN_F32) ld8((const float*)xin + off, xv[j]); else ld8h((const f16_t*)xin + off, xv[j]); }
            if (HAS_Y) {
                float yv[2][8]; float ss = 0.f;
#pragma unroll
                for (int j = 0; j < 2; ++j) { ld8h(y + m * D + 8 * F.lane + 512 * j, yv[j]);
#pragma unroll
                    for (int i = 0; i < 8; ++i) ss += yv[j][i] * yv[j][i]; }
                const float rstd = 1.0f / sqrtf(wave_sum(ss) * (1.0f / D) + EPS);
#pragma unroll
                for (int j = 0; j < 2; ++j)
#pragma unroll
                    for (int i = 0; i < 8; ++i) xv[j][i] += yv[j][i] * rstd * A[j][i];
            }
#pragma unroll
            for (int j = 0; j < 2; ++j) { const size_t off = m * D + 8 * F.lane + 512 * j;
                if (XOUT_F32) { *(f32x4*)((float*)xout + off) = (f32x4){xv[j][0], xv[j][1], xv[j][2], xv[j][3]}; *(f32x4*)((float*)xout + off + 4) = (f32x4){xv[j][4], xv[j][5], xv[j][6], xv[j][7]}; }
                else st8h((f16_t*)xout + off, xv[j]); }
            if (HAS_H) {
                float ss = 0.f;
#pragma unroll
                for (int j = 0; j < 2; ++j)
#pragma unroll
                    for (int i = 0; i < 8; ++i) ss += xv[j][i] * xv[j][i];
                const float rstd = 1.0f / sqrtf(wave_sum(ss) * (1.0f / D) + EPS);
#pragma unroll
                for (int j = 0; j < 2; ++j) { float o[8];
#pragma unroll
                    for (int i = 0; i < 8; ++i) o[i] = xv[j][i] * rstd * Bv[j][i] + Cv[j][i];
                    st8h(h + m * D + 8 * F.lane + 512 * j, o); }
            }
        }
    }
}

constexpr int NPH = 2 + 7 * DEPTH;
struct Args { const float* in[13]; float* out; unsigned char* ws; int ph_lo, ph_hi; };
__global__ void __launch_bounds__(NWAVES * 64, 2) fwd_kernel(Args args) {
    extern __shared__ __attribute__((aligned(16))) unsigned char lds[];
    Frame F;
    F.lds = (LAS unsigned char*)lds;
    volatile LAS unsigned* MISC = (volatile LAS unsigned*)(F.lds + MISC_OFF);
    F.tid = threadIdx.x; F.lane = F.tid & 63; F.wave = __builtin_amdgcn_readfirstlane(F.tid >> 6);
    F.G = gridDim.x; { const int bx = blockIdx.x; F.vcu = (F.G % 8 == 0) ? (bx % 8) * (F.G / 8) + bx / 8 : bx; }
    unsigned char* ws = args.ws;
    gu32* ctl = (gu32*)(ws + WS_CTL);
    const float* x_in = args.in[0]; const float* c_in = args.in[1]; const float* w_in = args.in[2]; const float* w_out = args.in[3]; const float* sinks = args.in[4];
    const float* rel_bias = args.in[5]; const float* w_ada = args.in[6]; const float* b_ada = args.in[7]; const float* gains = args.in[8];
    const float* w1 = args.in[9]; const float* b1 = args.in[10]; const float* w2 = args.in[11]; const float* b2 = args.in[12];
        float* mod = (float*)(ws + WS_MOD); float* kpart = (float*)(ws + WS_KPART);
    f16_t* HB = (f16_t*)(ws + WS_H); f16_t* YB = (f16_t*)(ws + WS_Y); f16_t* XB = (f16_t*)(ws + WS_X); f16_t* PROJ = (f16_t*)(ws + WS_PROJ); f16_t* ATT = (f16_t*)(ws + WS_ATT); f16_t* UB = (f16_t*)(ws + WS_U);
    for (int u = F.tid; u < (LDS_BYTES - LDSCTL_OFF) / 4; u += NWAVES * 64) ((LAS unsigned*)(F.lds + LDSCTL_OFF))[u] = 0u;
    __syncthreads();
    XcdBarrier bar; bar.bar = (unsigned*)(ctl + CW_BAR); bar.x = 0; bar.st = nullptr;
    if (!MK_PER_PHASE) bar = xcd_barrier_post((unsigned*)(ctl + CW_BAR), MISC + 8);
    const int lo = args.ph_lo, hi = args.ph_hi;
#define IN(k) (lo <= (k) && (k) < hi)
#define SEAM(k) do { if (IN(k) && IN((k) + 1)) xcd_barrier(bar); } while (0)

    if (IN(0)) { p0_prologue(F, c_in, w_ada, b_ada, mod, w_in, w_out, w1, w2, ws + WS_W); SEAM(0); }

    for (int l = 0; l < DEPTH; ++l) {
        const int pb = 1 + 7 * l;
        { int t_ = threadIdx.x; asm volatile("" : "+v"(t_)); F.tid = t_; F.lane = t_ & 63; }
        const float* modl = mod + (size_t)l * BATCH * 6 * D;
        const float* gl = gains + (size_t)l * 4 * D;
        unsigned char* wl = ws + WS_W + (size_t)l * W_LAYER;
        if (IN(pb + 0)) {
            if (l == 0) thin_phase<true, false, false, true>(F, x_in, nullptr, nullptr, nullptr, gl, modl + D, modl, XB, HB);
            else thin_phase<false, false, true, true>(F, XB, YB, modl - (size_t)BATCH * 6 * D + 5 * D, gl - 4 * D + 3 * D, gl, modl + D, modl, XB, HB);
            SEAM(pb + 0);
        }
        if (IN(pb + 1)) {
            pg8::Gemm g{HB, (const f16_t*)(wl + WO_IN), M, DIN, D}; pg8::StaticOrder S; S.init(M, DIN, F.G, (int)blockIdx.x);
            pg8::EpiProj E{PROJ, kpart, att::C2};
            pg8::gemm_phase<pg8::EpiProj, pg8::StaticOrder, true, true>(F.lds + RING_OFF, g, S, E);
            SEAM(pb + 1);
        }
        if (IN(pb + 2)) {
            for (int pi = F.vcu; pi < 256; pi += F.G) { const int bh = pi >> 2, s = pi & 3;
                att::moba_unit(bh >> 3, bh & 7, 7 - s, PROJ, ATT, kpart, rel_bias, F.lds + RING_OFF, F.tid, F.wave, F.lane);
                att::moba_unit(bh >> 3, bh & 7, s, PROJ, ATT, kpart, rel_bias, F.lds + RING_OFF, F.tid, F.wave, F.lane); }
            for (int u = F.vcu; u < 512; u += F.G)
                att::swa_unit(u >> 6, (u >> 5) & 1, u & 31, PROJ, ATT, sinks + l * 8, rel_bias, F.lds + RING_OFF, F.tid, F.wave, F.lane);
            SEAM(pb + 2);
        }
        if (IN(pb + 3)) {
            pg8::Gemm g{ATT, (const f16_t*)(wl + WO_OUT), M, D, D}; pg8::StaticOrder S; S.init(M, D, F.G, (int)blockIdx.x);
            pg8::EpiF16 E{YB, D, nullptr};
            pg8::gemm_phase<pg8::EpiF16, pg8::StaticOrder, true, true>(F.lds + RING_OFF, g, S, E);
            SEAM(pb + 3);
        }
        if (IN(pb + 4)) { thin_phase<false, false, true, true>(F, XB, YB, modl + 2 * D, gl + D, gl + 2 * D, modl + 4 * D, modl + 3 * D, XB, HB); SEAM(pb + 4); }
        if (IN(pb + 5)) {
            pg8::Gemm g{HB, (const f16_t*)(wl + WO_1), M, FF, D}; pg8::StaticOrder S; S.init(M, FF, F.G, (int)blockIdx.x);
            pg8::EpiSqRelu E{UB, FF, b1 + (size_t)l * FF};
            pg8::gemm_phase<pg8::EpiSqRelu, pg8::StaticOrder, true, true>(F.lds + RING_OFF, g, S, E);
            SEAM(pb + 5);
        }
        if (IN(pb + 6)) {
            pg8::Gemm g{UB, (const f16_t*)(wl + WO_2), M, D, FF}; pg8::StaticOrder S; S.init(M, D, F.G, (int)blockIdx.x);
            pg8::EpiF16 E{YB, D, b2 + (size_t)l * D};
            pg8::gemm_phase<pg8::EpiF16, pg8::StaticOrder, true, true>(F.lds + RING_OFF, g, S, E);
            SEAM(pb + 6);
        }
    }
    if (IN(NPH - 1)) {
        const float* modl = mod + (size_t)(DEPTH - 1) * BATCH * 6 * D; const float* gl = gains + (size_t)(DEPTH - 1) * 4 * D;
        thin_phase<false, true, true, false>(F, XB, YB, modl + 5 * D, gl + 3 * D, nullptr, nullptr, nullptr, args.out, nullptr);
    }
#undef IN
#undef SEAM
}

extern "C" void kernel_launch(void* const* d_in, const int* in_sizes, int n_in, void* d_out, int out_size, void* d_ws, size_t ws_size, hipStream_t stream) {
    static int grid = 0;
    if (grid == 0) {
        if (n_in != 13 || in_sizes[0] != M * D || out_size != M * D || ws_size < WS_END) { fprintf(stderr, "kernel_launch: unexpected shapes (n_in %d, in0 %d, out %d, ws %zu); nothing launched\n", n_in, n_in > 0 ? in_sizes[0] : -1, out_size, ws_size); grid = -1; return; }
        int dev = 0, cus = 0, per_cu = 0;
        if (hipGetDevice(&dev) != hipSuccess || hipDeviceGetAttribute(&cus, hipDeviceAttributeMultiprocessorCount, dev) != hipSuccess) { fprintf(stderr, "kernel_launch: device query failed\n"); grid = -1; return; }
        if (hipFuncSetAttribute((const void*)fwd_kernel, hipFuncAttributeMaxDynamicSharedMemorySize, LDS_BYTES) != hipSuccess) { fprintf(stderr, "kernel_launch: hipFuncSetAttribute failed\n"); grid = -1; return; }
        if (hipOccupancyMaxActiveBlocksPerMultiprocessor(&per_cu, (const void*)fwd_kernel, NWAVES * 64, LDS_BYTES) != hipSuccess || per_cu < 1)
            fprintf(stderr, "kernel_launch: note: occupancy query reports %d workgroups per CU\n", per_cu);
        (void)hipGetLastError();
        grid = cus;
    }
    if (grid < 0) return;
    if (hipMemsetAsync((char*)d_ws + WS_CTL, 0, CTL_ZERO_BYTES, stream) != hipSuccess) { fprintf(stderr, "kernel_launch: memset failed\n"); return; }
    Args a{};
    for (int i = 0; i < 13; ++i) a.in[i] = (const float*)d_in[i];
    a.out = (float*)d_out; a.ws = (unsigned char*)d_ws;
#if MK_PER_PHASE
    for (int p = 0; p < NPH; ++p) { a.ph_lo = p; a.ph_hi = p + 1; hipLaunchKernelGGL(fwd_kernel, dim3(grid), dim3(NWAVES * 64), LDS_BYTES, stream, a); }
#else
    a.ph_lo = 0; a.ph_hi = NPH;
    hipLaunchKernelGGL(fwd_kernel, dim3(grid), dim3(NWAVES * 64), LDS_BYTES, stream, a);
#endif
    const hipError_t le = hipPeekAtLastError();
    if (le != hipSuccess) fprintf(stderr, "kernel_launch: launch failed: %s\n", hipGetErrorName(le));
}
```
